# Optimizing an MI355X kernel written in HIP

```python
import math
import jax, jax.numpy as jnp
from jax import lax
import numpy as np

D_MODEL = 2048
BATCH = 2
SEQ = 8192
DEPTH = 2

CTX_LEN = 256
GRID_W = 64
HEAD_DIM = 128
ATTN_WIDTH = D_MODEL // 2
ATTN_HEADS = ATTN_WIDTH // HEAD_DIM
KV_HEADS = ATTN_HEADS // 4
GQA_GROUP = ATTN_HEADS // KV_HEADS
KV_WIDTH = KV_HEADS * HEAD_DIM
POOL_WIDTH = D_MODEL // 4
POOL_WINDOWS = (2, 4, 8, 16)
POOL_GROUP = POOL_WIDTH // len(POOL_WINDOWS)
CONV_WIDTH = D_MODEL // 4
CONV_K = 3
D_FF = 4 * D_MODEL
Q_BLOCK = 128
ROPE_BASE = 10000.0
EPS = 1e-6
ATTN_SCALE = 1.0 / math.sqrt(HEAD_DIM)

K_OFF = ATTN_WIDTH
V_OFF = K_OFF + KV_WIDTH
POOL_OFF = V_OFF + KV_WIDTH
CB_OFF = POOL_OFF + POOL_WIDTH
CC_OFF = CB_OFF + CONV_WIDTH
CV_OFF = CC_OFF + CONV_WIDTH
IN_WIDTH = CV_OFF + CONV_WIDTH
MIX_WIDTH = ATTN_WIDTH + POOL_WIDTH + CONV_WIDTH

kernel_name = "hybrid_pool_conv_gqa_diffusion_block"


def _rmsnorm(x, g):
    x32 = x.astype(jnp.float32)
    y = x32 * lax.rsqrt(jnp.mean(x32 * x32, axis=-1, keepdims=True) + EPS)
    return (y * g.astype(jnp.float32)).astype(x.dtype)


def _axial_rope(n):
    rows = n // GRID_W
    row = jnp.repeat(jnp.arange(rows, dtype=jnp.float32), GRID_W)
    col = jnp.tile(jnp.arange(GRID_W, dtype=jnp.float32), rows)
    n_freq = HEAD_DIM // 4
    inv = ROPE_BASE ** (-jnp.arange(n_freq, dtype=jnp.float32) / n_freq)
    ang_r = row[:, None] * inv
    ang_c = col[:, None] * inv
    ang = jnp.concatenate([ang_r, ang_r, ang_c, ang_c], axis=-1)
    return jnp.cos(ang), jnp.sin(ang)


def _rope(x, cos, sin):
    x1, x2, x3, x4 = jnp.split(x, 4, axis=-1)
    rot = jnp.concatenate([-x2, x1, -x4, x3], axis=-1)
    return (x * cos + rot * sin).astype(x.dtype)


def _attend(q, k, v):
    s = jnp.einsum('bqhgd,bkhd->bhgqk', q, k, preferred_element_type=jnp.float32) * ATTN_SCALE
    p = jax.nn.softmax(s, axis=-1)
    return jnp.einsum('bhgqk,bkhd->bqhgd', p.astype(v.dtype), v, preferred_element_type=jnp.float32)


def _latent_attention(q, k, v, kc, vc, qg, kg, cos, sin):
    b, n, _ = q.shape
    q = q.reshape(b, n, KV_HEADS, GQA_GROUP, HEAD_DIM)
    k = k.reshape(b, n, KV_HEADS, HEAD_DIM)
    v = v.reshape(b, n, KV_HEADS, HEAD_DIM)
    q = _rope(_rmsnorm(q, qg), cos[:, None, None, :], sin[:, None, None, :])
    k = _rope(_rmsnorm(k, kg), cos[:, None, :], sin[:, None, :])
    keys = jnp.concatenate([kc.astype(k.dtype), k], axis=1)
    vals = jnp.concatenate([vc.astype(v.dtype), v], axis=1)
    nb = n // Q_BLOCK
    qb = q.reshape(b, nb, Q_BLOCK, KV_HEADS, GQA_GROUP, HEAD_DIM).swapaxes(0, 1)
    out = lax.map(lambda qq: _attend(qq, keys, vals), qb)
    return out.swapaxes(0, 1).reshape(b, n, ATTN_WIDTH).astype(q.dtype)


def _context_attention(qc, kc, vc, qg):
    b, m, _ = qc.shape
    qc = _rmsnorm(qc.reshape(b, m, KV_HEADS, GQA_GROUP, HEAD_DIM), qg)
    return _attend(qc, kc, vc).reshape(b, m, ATTN_WIDTH).astype(qc.dtype)


def _pool_mixer(u, w_pool, pool_scale):
    b, n, _ = u.shape
    u32 = u.astype(jnp.float32)
    csum = jnp.concatenate([jnp.zeros((b, 1, POOL_WIDTH), jnp.float32), jnp.cumsum(u32, axis=1)], axis=1)
    t = jnp.arange(n)
    diffs = []
    for gi, w in enumerate(POOL_WINDOWS):
        lo = w // 2
        hi = w - 1 - lo
        start = jnp.clip(t - lo, 0, n)
        end = jnp.clip(t + hi + 1, 0, n)
        seg = csum[:, :, gi * POOL_GROUP:(gi + 1) * POOL_GROUP]
        cnt = (end - start).astype(jnp.float32)[None, :, None]
        diffs.append((seg[:, end] - seg[:, start]) / cnt - u32[..., gi * POOL_GROUP:(gi + 1) * POOL_GROUP])
    d = jnp.stack(diffs, axis=2)
    y = jnp.einsum('bngc,gce->bnge', d, w_pool.astype(jnp.float32)).reshape(b, n, POOL_WIDTH)
    return (y * pool_scale.astype(jnp.float32)).astype(u.dtype)


def _short_conv_mixer(gb, gc, v, conv_w):
    z = gc * v
    rhs = conv_w[:, None, :].astype(z.dtype)
    conv = lax.conv_general_dilated(z, rhs, window_strides=(1,), padding=[(CONV_K // 2, CONV_K // 2)],
                                    dimension_numbers=('NWC', 'WIO', 'NWC'), feature_group_count=CONV_WIDTH)
    return gb * conv


def _mix_out(att, pu, gb, gc, cv, w_pool, pool_scale, conv_w, w_out):
    pool = _pool_mixer(pu, w_pool, pool_scale)
    conv = _short_conv_mixer(gb, gc, cv, conv_w)
    cat = jnp.concatenate([att, pool.astype(att.dtype), conv.astype(att.dtype)], axis=-1)
    return jnp.einsum('bne,ed->bnd', cat, w_out)


def _sqrelu_mlp(h, w1, w2):
    u = jax.nn.relu(jnp.einsum('bnd,df->bnf', h, w1))
    return jnp.einsum('bnf,fd->bnd', u * u, w2)


def _split_in(p):
    return jnp.split(p, [K_OFF, V_OFF, POOL_OFF, CB_OFF, CC_OFF, CV_OFF], axis=-1)


def setup_inputs(seed: int = 0) -> dict:
    key = jax.random.key(seed)
    ks = jax.random.split(key, 20)
    f32 = jnp.float32
    nrm = lambda k, shape, s: jax.random.normal(k, shape, f32) * s
    return {
        "x": nrm(ks[0], (BATCH, SEQ, D_MODEL), 1.0),
        "c": nrm(ks[1], (BATCH, D_MODEL), 1.0),
        "ctx": nrm(ks[2], (BATCH, CTX_LEN, D_MODEL), 1.0),
        "c_ctx": nrm(ks[3], (D_MODEL,), 1.0),
        "w_mod": nrm(ks[4], (DEPTH, D_MODEL, 6 * D_MODEL), 0.5 * D_MODEL ** -0.5),
        "b_mod": nrm(ks[5], (DEPTH, 6 * D_MODEL), 0.02),
        "norm1_g": 1.0 + nrm(ks[6], (DEPTH, D_MODEL), 0.05),
        "norm2_g": 1.0 + nrm(ks[7], (DEPTH, D_MODEL), 0.05),
        "w_in": nrm(ks[8], (DEPTH, D_MODEL, IN_WIDTH), D_MODEL ** -0.5),
        "q_norm_g": 1.0 + nrm(ks[9], (DEPTH, HEAD_DIM), 0.05),
        "k_norm_g": 1.0 + nrm(ks[10], (DEPTH, HEAD_DIM), 0.05),
        "w_pool": nrm(ks[11], (DEPTH, len(POOL_WINDOWS), POOL_GROUP, POOL_GROUP), POOL_GROUP ** -0.5),
        "pool_scale": 1.0 + nrm(ks[12], (DEPTH, POOL_WIDTH), 0.1),
        "conv_w": nrm(ks[13], (DEPTH, CONV_K, CONV_WIDTH), CONV_K ** -0.5),
        "w_out": nrm(ks[14], (DEPTH, MIX_WIDTH, D_MODEL), MIX_WIDTH ** -0.5),
        "w_ff1": nrm(ks[15], (DEPTH, D_MODEL, D_FF), D_MODEL ** -0.5),
        "w_ff2": nrm(ks[16], (DEPTH, D_FF, D_MODEL), D_FF ** -0.5),
    }


def reference(x, c, ctx, c_ctx, w_mod, b_mod, norm1_g, norm2_g, w_in, q_norm_g, k_norm_g,
              w_pool, pool_scale, conv_w, w_out, w_ff1, w_ff2):
    b, n, _ = x.shape
    m = ctx.shape[1]
    cos, sin = _axial_rope(n)
    c_act = jax.nn.silu(c)
    cc_act = jax.nn.silu(c_ctx)
    xc = ctx
    for l in range(DEPTH):
        last = l == DEPTH - 1
        mod = jnp.einsum('bd,de->be', c_act, w_mod[l]) + b_mod[l]
        sh1, sc1, gt1, sh2, sc2, gt2 = jnp.split(mod[:, None, :], 6, axis=-1)
        modc = jnp.einsum('d,de->e', cc_act, w_mod[l]) + b_mod[l]
        csh1, csc1, cgt1, csh2, csc2, cgt2 = jnp.split(modc, 6)

        hc = _rmsnorm(xc, norm1_g[l]) * (1.0 + csc1) + csh1
        if last:
            kc, vc = jnp.split(jnp.einsum('bnd,de->bne', hc, w_in[l][:, K_OFF:POOL_OFF]), 2, axis=-1)
        else:
            qc, kc, vc, puc, cbc, ccc, cvc = _split_in(jnp.einsum('bnd,de->bne', hc, w_in[l]))
        kc = _rmsnorm(kc.reshape(b, m, KV_HEADS, HEAD_DIM), k_norm_g[l])
        vc = vc.reshape(b, m, KV_HEADS, HEAD_DIM)

        h = _rmsnorm(x, norm1_g[l]) * (1.0 + sc1) + sh1
        q, k, v, pu, cb, cc, cv = _split_in(jnp.einsum('bnd,de->bne', h, w_in[l]))
        att = _latent_attention(q, k, v, kc, vc, q_norm_g[l], k_norm_g[l], cos, sin)
        x = x + gt1 * _mix_out(att, pu, cb, cc, cv, w_pool[l], pool_scale[l], conv_w[l], w_out[l])
        h2 = _rmsnorm(x, norm2_g[l]) * (1.0 + sc2) + sh2
        x = x + gt2 * _sqrelu_mlp(h2, w_ff1[l], w_ff2[l])

        if not last:
            attc = _context_attention(qc, kc, vc, q_norm_g[l])
            xc = xc + cgt1 * _mix_out(attc, puc, cbc, ccc, cvc, w_pool[l], pool_scale[l], conv_w[l], w_out[l])
            hc2 = _rmsnorm(xc, norm2_g[l]) * (1.0 + csc2) + csh2
            xc = xc + cgt2 * _sqrelu_mlp(hc2, w_ff1[l], w_ff2[l])
    return x
```

```cpp
#include <hip/hip_runtime.h>
#include <hip/hip_bf16.h>
#include <hip/hip_cooperative_groups.h>
#include <cstdio>
#include <cstdint>
namespace cg = cooperative_groups;

constexpr int DM = 2048, NB = 2, SEQ = 8192, CTX = 256, RPB = SEQ + CTX, MROWS = NB * RPB;
constexpr int INW = 3584, DFF = 8192, HD = 128, TPB = RPB / 256;
constexpr int Q_OFF = 0, K_OFF = 1024, V_OFF = 1280, POOL_OFF = 1536, CB_OFF = 2048, CC_OFF = 2560, CV_OFF = 3072;
constexpr float EPS = 1e-6f;
constexpr int NWAVES = 8, NTHREADS = 512;

constexpr size_t MiB = 1u << 20;
constexpr size_t WS_CTL = 0, CTL_BYTES = 1 * MiB;
constexpr size_t WS_MOD = 1 * MiB;
constexpr size_t WS_ROPE = 2 * MiB;
constexpr size_t WS_W = 4 * MiB, WL_BYTES = 86 * MiB;
constexpr size_t WO_IN = 0, WO_OUT = 14 * MiB, WO_FF1 = 22 * MiB, WO_FF2 = 54 * MiB;
constexpr size_t WS_X = WS_W + 2 * WL_BYTES;
constexpr size_t WS_H = WS_X + 132 * MiB;
constexpr size_t WS_U = WS_H + 66 * MiB;
constexpr size_t WS_P = WS_U;
constexpr size_t WS_CAT = WS_U + 116 * MiB;
constexpr size_t WS_KV = WS_CAT + 66 * MiB;
constexpr size_t WS_QN = WS_KV + 17 * MiB;
constexpr size_t WS_END = WS_U + 264 * MiB;
static_assert(WS_KV + (size_t)MROWS * 512 * 2 <= WS_QN && WS_QN + (size_t)MROWS * 1024 * 2 <= WS_END, "overlay");

constexpr int RING_BYTES = 131072, LDS_BYTES = 147456;

typedef unsigned short bf16raw;
typedef unsigned v4u __attribute__((ext_vector_type(4)));
typedef unsigned v2u __attribute__((ext_vector_type(2)));
typedef float v4f __attribute__((ext_vector_type(4)));
#define LAS __attribute__((address_space(3)))

__device__ __forceinline__ unsigned f2bf(float f) { unsigned u = __builtin_bit_cast(unsigned, f); return (u + 0x7fffu + ((u >> 16) & 1u)) >> 16; }
__device__ __forceinline__ unsigned pk2(float lo, float hi) { return f2bf(lo) | (f2bf(hi) << 16); }
__device__ __forceinline__ float bflo(unsigned w) { return __builtin_bit_cast(float, w << 16); }
__device__ __forceinline__ float bfhi(unsigned w) { return __builtin_bit_cast(float, w & 0xffff0000u); }
__device__ __forceinline__ void unpack8(v4u r, float* x) { x[0] = bflo(r.x); x[1] = bfhi(r.x); x[2] = bflo(r.y); x[3] = bfhi(r.y); x[4] = bflo(r.z); x[5] = bfhi(r.z); x[6] = bflo(r.w); x[7] = bfhi(r.w); }
__device__ __forceinline__ v4u pack8(const float* x) { v4u o; o.x = pk2(x[0], x[1]); o.y = pk2(x[2], x[3]); o.z = pk2(x[4], x[5]); o.w = pk2(x[6], x[7]); return o; }
__device__ __forceinline__ float wave_sum(float v) {
#pragma unroll
    for (int o = 1; o < 64; o <<= 1) v += __shfl_xor(v, o);
    return v;
}

__device__ __forceinline__ int fresh_tid() { int t = threadIdx.x; asm volatile("" : "+v"(t)); return t; }
__device__ __forceinline__ int fresh_bid() { int b = blockIdx.x; asm volatile("" : "+s"(b)); return b; }

namespace pg8 {
#define PG8_LAS __attribute__((address_space(3)))
typedef unsigned short bf16_t;
typedef short bf16x8 __attribute__((ext_vector_type(8)));
typedef float f32x4 __attribute__((ext_vector_type(4)));
typedef unsigned u32x4 __attribute__((ext_vector_type(4)));
constexpr int BM = 256, BK = 64, HALF = 128, HTB = HALF * BK * 2  , STAGE_BYTES = 8 * HTB, NXCD = 8, WGM = 8;

__host__ __device__ __forceinline__ int lds_byte(int r, int c) { const int st = (r >> 4) * 2 + (c >> 5), rr = r & 15, cc = c & 31, ob = rr * 64 + cc * 2; return st * 1024 + (ob ^ (((ob >> 9) & 1) << 5)); }
__host__ __device__ __forceinline__ void stage_rc(int b, int& R, int& C) { const int st = b / 1024, sb = b % 1024, swz = sb ^ (((sb >> 9) & 1) << 5); R = (st >> 1) * 16 + swz / 64; C = (st & 1) * 32 + (swz % 64) / 2; }
__host__ __device__ __forceinline__ int perm32(int rho) { const int n = rho >> 4, i = rho & 15; return 8 * (i >> 2) + 4 * n + (i & 3); }

struct Unit { int pm, pn; };
struct Gemm { const bf16_t* A; const bf16_t* Bt; int M, N, K, ld; };

struct TileOrder {
    int nM, nN, nMain, nwg, G, c, mode;
    __device__ void init(int N, int G_, int c_, int mode_) { mode = mode_; nM = mode_ == 0 ? 66 : 64; nN = N / BM; nMain = nM * nN; nwg = nMain + (mode_ == 2 ? 4 : 0); G = G_; c = c_; }
    __device__ bool next(int i, Unit& u) const {
        const long L = (long)i * G + c; if (L >= nwg) return false;
        int wgid = (int)L; { const int q = nwg / NXCD, r = nwg % NXCD, xcd = wgid % NXCD, off = wgid / NXCD; wgid = (xcd < r ? xcd * (q + 1) : r * (q + 1) + (xcd - r) * q) + off; }
        if (wgid >= nMain) { const int e = wgid - nMain; u.pm = (e >> 1) * 33; u.pn = 4 + (e & 1); return true; }
        const int nig = WGM * nN, gid = wgid / nig, fm = gid * WGM, gsz = (nM - fm) < WGM ? (nM - fm) : WGM;
        const int mt = fm + ((wgid % nig) % gsz); u.pn = (wgid % nig) / gsz;
        u.pm = mode == 0 ? mt : (mt >> 5) * 33 + 1 + (mt & 31); return true;
    }
    __device__ __forceinline__ void a_ready(const Unit&) const {}
    __device__ __forceinline__ void done(const Unit&) const {}
};
struct OneUnit {
    int pm, pn, has;
    __device__ __forceinline__ bool next(int i, Unit& u) const { if (i != 0 || !has) return false; u.pm = pm; u.pn = pn; return true; }
    __device__ __forceinline__ void a_ready(const Unit&) const {}
    __device__ __forceinline__ void done(const Unit&) const {}
};
__device__ __forceinline__ unsigned cvt_pk_bf16(float lo, float hi) { unsigned r; asm volatile("v_cvt_pk_bf16_f32 %0, %1, %2" : "=v"(r) : "v"(lo), "v"(hi)); return r; }
typedef float f32x2 __attribute__((ext_vector_type(2)));
template <int ACT  > struct EpiBf16 {
    static constexpr bool PERM = true, AFTER_DRAIN = false;
    bf16_t* O; int ldc;
    __device__ __forceinline__ void operator()(const f32x4 (&acc)[2][2][4][2], const Unit& u, int wr, int wc, int fr, int fq) const {
        const int row0 = u.pm * BM + wr * 64 + fr; const int col0 = u.pn * BM + wc * 32 + 8 * fq;
#pragma unroll
        for (int ai = 0; ai < 2; ++ai)
#pragma unroll
            for (int m = 0; m < 4; ++m) { bf16_t* rowp = O + (size_t)(row0 + ai * HALF + m * 16) * ldc + col0;
#pragma unroll
                for (int bj = 0; bj < 2; ++bj) { f32x4 v0 = acc[ai][bj][m][0], v1 = acc[ai][bj][m][1];
                    if (ACT == 2) { const f32x4 z = {0.f, 0.f, 0.f, 0.f}; v0 = __builtin_elementwise_max(v0, z); v1 = __builtin_elementwise_max(v1, z); v0 = v0 * v0; v1 = v1 * v1; }
                    u32x4 w; w.x = cvt_pk_bf16(v0[0], v0[1]); w.y = cvt_pk_bf16(v0[2], v0[3]); w.z = cvt_pk_bf16(v1[0], v1[1]); w.w = cvt_pk_bf16(v1[2], v1[3]);
                    *(u32x4*)(rowp + bj * HALF) = w; } }
    }
};
struct EpiGateRes {
    static constexpr bool PERM = true, AFTER_DRAIN = false;
    const float* gate;
    const float* xin; const float* ctxin;
    bf16_t* X; float* out;
    int in_mode, out_mode;
    __device__ __forceinline__ void operator()(const f32x4 (&acc)[2][2][4][2], const Unit& u, int wr, int wc, int fr, int fq) const {
        const int b = u.pm / 33, jt = u.pm % 33, s = jt == 0 ? 2 : b;
        const size_t lat_off = ((size_t)b * 8192 + (size_t)(jt - 1) * 256) * 2048;
        const float* basef = jt == 0 ? ctxin + (size_t)b * 256 * 2048 : xin + lat_off;
        bf16_t* xb = X + (size_t)u.pm * 256 * 2048; float* outf = out + lat_off;
        const int col0 = u.pn * BM + wc * 32 + 8 * fq; const float* gp = gate + (size_t)s * 12288 + col0;
        f32x4 gv[2][2];
#pragma unroll
        for (int bj = 0; bj < 2; ++bj)
#pragma unroll
            for (int n = 0; n < 2; ++n) gv[bj][n] = *(const f32x4*)(gp + bj * HALF + n * 4);
#pragma unroll
        for (int ai = 0; ai < 2; ++ai)
#pragma unroll
            for (int m = 0; m < 4; ++m) { const size_t off = (size_t)(ai * HALF + wr * 64 + m * 16 + fr) * 2048 + col0;
#pragma unroll
                for (int bj = 0; bj < 2; ++bj) { f32x4 b0, b1;
                    if (in_mode) { b0 = *(const f32x4*)(basef + off + bj * HALF); b1 = *(const f32x4*)(basef + off + bj * HALF + 4); }
                    else { const u32x4 w = *(const u32x4*)(xb + off + bj * HALF);
                        b0 = (f32x4){__builtin_bit_cast(float, w.x << 16), __builtin_bit_cast(float, w.x & 0xffff0000u), __builtin_bit_cast(float, w.y << 16), __builtin_bit_cast(float, w.y & 0xffff0000u)};
                        b1 = (f32x4){__builtin_bit_cast(float, w.z << 16), __builtin_bit_cast(float, w.z & 0xffff0000u), __builtin_bit_cast(float, w.w << 16), __builtin_bit_cast(float, w.w & 0xffff0000u)}; }
                    const f32x4 o0 = b0 + gv[bj][0] * acc[ai][bj][m][0], o1 = b1 + gv[bj][1] * acc[ai][bj][m][1];
                    if (out_mode) { *(f32x4*)(outf + off + bj * HALF) = o0; *(f32x4*)(outf + off + bj * HALF + 4) = o1; }
                    else { u32x4 w; w.x = cvt_pk_bf16(o0[0], o0[1]); w.y = cvt_pk_bf16(o0[2], o0[3]); w.z = cvt_pk_bf16(o1[0], o1[1]); w.w = cvt_pk_bf16(o1[2], o1[3]); *(u32x4*)(xb + off + bj * HALF) = w; } }
                if (m & 1) asm volatile("" ::: "memory"); }
    }
};

struct EpiGateAtomic {
    static constexpr bool PERM = false, AFTER_DRAIN = false;
    const float* gate; float* X;
    __device__ __forceinline__ void operator()(const f32x4 (&acc)[2][2][4][2], const Unit& u, int wr, int wc, int fr, int fq) const {
        const int b = u.pm / 33, jt = u.pm % 33, s = jt == 0 ? 2 : b;
        float* outp = X + (size_t)u.pm * 256 * 2048;
        const int col0 = u.pn * BM + wc * 32 + 4 * fq; const float* gp = gate + (size_t)s * 12288 + col0;
        f32x4 gv[2][2];
#pragma unroll
        for (int bj = 0; bj < 2; ++bj)
#pragma unroll
            for (int n = 0; n < 2; ++n) gv[bj][n] = *(const f32x4*)(gp + bj * HALF + n * 16);
#pragma unroll
        for (int ai = 0; ai < 2; ++ai)
#pragma unroll
            for (int m = 0; m < 4; ++m) { const size_t off = (size_t)(ai * HALF + wr * 64 + m * 16 + fr) * 2048 + col0;
#pragma unroll
                for (int bj = 0; bj < 2; ++bj)
#pragma unroll
                    for (int n = 0; n < 2; ++n) { const f32x4 v = gv[bj][n] * acc[ai][bj][m][n]; float* p = outp + off + bj * HALF + n * 16;
#pragma unroll
                        for (int e = 0; e < 4; ++e) (void)__hip_atomic_fetch_add(p + e, v[e], __ATOMIC_RELAXED, __HIP_MEMORY_SCOPE_AGENT); } }
    }
};

struct EpiSlab {
    static constexpr bool PERM = false, AFTER_DRAIN = false;
    float* slab;
    __device__ __forceinline__ void operator()(const f32x4 (&acc)[2][2][4][2], const Unit& u, int wr, int wc, int fr, int fq) const {
        float* outp = slab + (size_t)(u.pm / 33) * 256 * 2048;
        const int col0 = u.pn * BM + wc * 32 + 4 * fq;
#pragma unroll
        for (int ai = 0; ai < 2; ++ai)
#pragma unroll
            for (int m = 0; m < 4; ++m) { const size_t off = (size_t)(ai * HALF + wr * 64 + m * 16 + fr) * 2048 + col0;
#pragma unroll
                for (int bj = 0; bj < 2; ++bj)
#pragma unroll
                    for (int n = 0; n < 2; ++n) *(f32x4*)(outp + off + bj * HALF + n * 16) = acc[ai][bj][m][n]; }
    }
};

template <class Epi, class Sched, bool ALIGN_EPI = false, bool SP2 = false>
__device__ __forceinline__ void gemm_phase(PG8_LAS unsigned char* lds, const Gemm g, const Sched& S, const Epi& E) {
    const int tid = fresh_tid(), wid = __builtin_amdgcn_readfirstlane(tid >> 6), lane = tid & 63, wr = wid >> 2, wc = wid & 3, fr = lane & 15, fq = lane >> 4;
    const int K = g.ld, nt = g.K / BK;
    unsigned voffA[2], voffB[2];
#pragma unroll
    for (int i = 0; i < 2; ++i) { int R, C; stage_rc(tid * 16 + i * 8192, R, C); const int Rb = Epi::PERM ? ((R & ~31) + perm32(R & 31)) : R;
        voffA[i] = (unsigned)(R * K + C) * 2u; voffB[i] = (unsigned)(Rb * K + C) * 2u; }
    const size_t kstep = (size_t)(BK * 2);
    const size_t hstep = (size_t)HALF * K * 2;
    const size_t tstep = 2 * hstep;
    const unsigned ldsw = (unsigned)wid * 1024u;
    const int aoff = lds_byte(wr * 64 + fr, fq * 8), boff = lds_byte(wc * 32 + fr, fq * 8);
#define PG8_SA(b, h) (((b) * 2 + (h)) * HTB)
#define PG8_SB(b, h) ((4 + (b) * 2 + (h)) * HTB)
#define PG8_STAGE(bufoff, gbase, voff) do { _Pragma("unroll") for (int _i = 0; _i < 2; ++_i) \
        __builtin_amdgcn_global_load_lds((const unsigned*)((const char*)(gbase) + (voff)[_i]), (PG8_LAS unsigned*)(lds + (bufoff) + ldsw + _i * 8192), 16, 0, 0); } while (0)
#define PG8_LDA(dst, b, h) do { _Pragma("unroll") for (int m = 0; m < 4; ++m) _Pragma("unroll") for (int k = 0; k < 2; ++k) dst[m][k] = *(const PG8_LAS bf16x8*)(lds + PG8_SA(b, h) + aoff + m * 2048 + k * 1024); } while (0)
#define PG8_LDB(dst, b, h) do { _Pragma("unroll") for (int n = 0; n < 2; ++n) _Pragma("unroll") for (int k = 0; k < 2; ++k) dst[n][k] = *(const PG8_LAS bf16x8*)(lds + PG8_SB(b, h) + boff + n * 2048 + k * 1024); } while (0)
#define PG8_MMA(ai, bj, At, Bt) do { __builtin_amdgcn_s_setprio(1); _Pragma("unroll") for (int m = 0; m < 4; ++m) _Pragma("unroll") for (int n = 0; n < 2; ++n) _Pragma("unroll") for (int k = 0; k < 2; ++k) \
        acc[ai][bj][m][n] = __builtin_amdgcn_mfma_f32_16x16x32_bf16(Bt[n][k], At[m][k], acc[ai][bj][m][n], 0, 0, 0); __builtin_amdgcn_s_setprio(0); } while (0)
#define PG8_WAIT_V(n) asm volatile("s_waitcnt vmcnt(" #n ")" ::: "memory")
#define PG8_WAIT_L(n) asm volatile("s_waitcnt lgkmcnt(" #n ")" ::: "memory")
#define PG8_BAR __builtin_amdgcn_s_barrier()
#define PG8_SCHED __builtin_amdgcn_sched_barrier(0)
    Unit cur, nxt; int ui = 0;
    if (!S.next(0, cur)) return;
    f32x4 acc[2][2][4][2];
#pragma unroll
    for (int a = 0; a < 2; ++a)
#pragma unroll
        for (int b = 0; b < 2; ++b)
#pragma unroll
            for (int m = 0; m < 4; ++m)
#pragma unroll
                for (int n = 0; n < 2; ++n) acc[a][b][m][n] = (f32x4){0.f, 0.f, 0.f, 0.f};
    bf16x8 At[4][2], B0[2][2], B1[2][2];
    const char* cA = (const char*)g.A + (size_t)cur.pm * tstep; const char* cB = (const char*)g.Bt + (size_t)cur.pn * tstep;
    S.a_ready(cur);
    if constexpr (SP2) {
        PG8_STAGE(PG8_SB(0, 0), cB, voffB); PG8_STAGE(PG8_SB(0, 1), cB + hstep, voffB); PG8_STAGE(PG8_SA(0, 0), cA, voffA); PG8_STAGE(PG8_SA(0, 1), cA + hstep, voffA);
        if (wr == 1) PG8_BAR;
        PG8_WAIT_V(2); PG8_BAR;
        PG8_STAGE(PG8_SB(1, 0), cB + kstep, voffB); PG8_STAGE(PG8_SA(1, 0), cA + kstep, voffA); PG8_STAGE(PG8_SB(1, 1), cB + hstep + kstep, voffB);
        PG8_WAIT_V(6); PG8_BAR;
    } else {
        PG8_STAGE(PG8_SB(0, 0), cB, voffB); PG8_STAGE(PG8_SA(0, 0), cA, voffA); PG8_STAGE(PG8_SB(0, 1), cB + hstep, voffB); PG8_STAGE(PG8_SA(0, 1), cA + hstep, voffA);
        if (wr == 1) PG8_BAR;
        PG8_WAIT_V(4); PG8_BAR;
        PG8_STAGE(PG8_SB(1, 0), cB + kstep, voffB); PG8_STAGE(PG8_SA(1, 0), cA + kstep, voffA); PG8_STAGE(PG8_SB(1, 1), cB + hstep + kstep, voffB);
        PG8_WAIT_V(6); PG8_BAR;
    }
    for (;;) {
        const bool has_next = S.next(ui + 1, nxt);
        const char* nA = has_next ? (const char*)g.A + (size_t)nxt.pm * tstep : cA; const char* nB = has_next ? (const char*)g.Bt + (size_t)nxt.pn * tstep : cB;
        for (int t = 0; t < nt; t += 2) {
            const bool last = (t == nt - 2);
            const char* a1 = cA + (size_t)(t + 1) * kstep;
            const char* a2 = last ? nA : cA + (size_t)(t + 2) * kstep; const char* b2 = last ? nB : cB + (size_t)(t + 2) * kstep;
            const char* a3 = a2 + kstep; const char* b3 = b2 + kstep;
            if (last && has_next) S.a_ready(nxt);
            if constexpr (SP2) {
            PG8_LDB(B0, 0, 0); PG8_LDB(B1, 0, 1); PG8_SCHED; PG8_LDA(At, 0, 0); PG8_STAGE(PG8_SA(1, 1), a1 + hstep, voffA);
            PG8_WAIT_V(8); PG8_WAIT_L(0); PG8_BAR; PG8_MMA(0, 0, At, B0); PG8_MMA(0, 1, At, B1); PG8_BAR; PG8_SCHED;
            PG8_LDA(At, 0, 1); PG8_STAGE(PG8_SB(0, 0), b2, voffB); PG8_STAGE(PG8_SB(0, 1), b2 + hstep, voffB); PG8_STAGE(PG8_SA(0, 0), a2, voffA);
            PG8_WAIT_V(8); PG8_WAIT_L(0); PG8_BAR; PG8_MMA(1, 0, At, B0); PG8_MMA(1, 1, At, B1); PG8_BAR; PG8_SCHED;
            PG8_LDB(B0, 1, 0); PG8_LDB(B1, 1, 1); PG8_SCHED; PG8_LDA(At, 1, 0); PG8_STAGE(PG8_SA(0, 1), a2 + hstep, voffA);
            PG8_WAIT_V(8); PG8_WAIT_L(0); PG8_BAR; PG8_MMA(0, 0, At, B0); PG8_MMA(0, 1, At, B1); PG8_BAR; PG8_SCHED;
            PG8_LDA(At, 1, 1); PG8_STAGE(PG8_SB(1, 0), b3, voffB); PG8_STAGE(PG8_SB(1, 1), b3 + hstep, voffB); PG8_STAGE(PG8_SA(1, 0), a3, voffA);
            PG8_WAIT_V(8); PG8_WAIT_L(0); PG8_BAR; PG8_MMA(1, 0, At, B0); PG8_MMA(1, 1, At, B1); PG8_BAR; PG8_SCHED;
            } else {
            PG8_LDB(B0, 0, 0); PG8_SCHED; PG8_LDA(At, 0, 0); PG8_STAGE(PG8_SA(1, 1), a1 + hstep, voffA);
            PG8_WAIT_L(8); PG8_BAR; PG8_WAIT_L(0); PG8_MMA(0, 0, At, B0); PG8_BAR; PG8_SCHED;
            PG8_LDB(B1, 0, 1); PG8_STAGE(PG8_SB(0, 0), b2, voffB);
            PG8_BAR; PG8_WAIT_L(0); PG8_MMA(0, 1, At, B1); PG8_BAR;
            PG8_LDA(At, 0, 1); PG8_STAGE(PG8_SA(0, 0), a2, voffA);
            PG8_BAR; PG8_WAIT_L(0); PG8_MMA(1, 0, At, B0); PG8_BAR; PG8_SCHED;
            PG8_STAGE(PG8_SB(0, 1), b2 + hstep, voffB);
            PG8_WAIT_V(6); PG8_BAR; PG8_MMA(1, 1, At, B1); PG8_BAR;
            PG8_LDB(B0, 1, 0); PG8_SCHED; PG8_LDA(At, 1, 0); PG8_STAGE(PG8_SA(0, 1), a2 + hstep, voffA);
            PG8_WAIT_L(8); PG8_BAR; PG8_WAIT_L(0); PG8_MMA(0, 0, At, B0); PG8_BAR; PG8_SCHED;
            PG8_LDB(B1, 1, 1); PG8_STAGE(PG8_SB(1, 0), b3, voffB);
            PG8_BAR; PG8_WAIT_L(0); PG8_MMA(0, 1, At, B1); PG8_BAR;
            PG8_LDA(At, 1, 1); PG8_STAGE(PG8_SA(1, 0), a3, voffA);
            PG8_BAR; PG8_WAIT_L(0); PG8_MMA(1, 0, At, B0); PG8_BAR; PG8_SCHED;
            PG8_STAGE(PG8_SB(1, 1), b3 + hstep, voffB);
            PG8_WAIT_V(6); PG8_BAR; PG8_MMA(1, 1, At, B1); PG8_BAR;
            }
        }
        if constexpr (ALIGN_EPI) { if (wr == 0) PG8_BAR; }
        if constexpr (!Epi::AFTER_DRAIN) { E(acc, cur, wr, wc, fr, fq); S.done(cur); }
        if (!has_next) break;
#pragma unroll
        for (int a = 0; a < 2; ++a)
#pragma unroll
            for (int b = 0; b < 2; ++b)
#pragma unroll
                for (int m = 0; m < 4; ++m)
#pragma unroll
                    for (int n = 0; n < 2; ++n) acc[a][b][m][n] = (f32x4){0.f, 0.f, 0.f, 0.f};
        cur = nxt; cA = nA; cB = nB; ++ui;
        if constexpr (ALIGN_EPI) { if (wr == 1) PG8_BAR; }
    }
    PG8_WAIT_V(0);
    if constexpr (!ALIGN_EPI) { if (wr == 0) PG8_BAR; }
    PG8_BAR;
    if constexpr (Epi::AFTER_DRAIN) { E.fused(acc, cur, wr, wc, fr, fq, lds, wid, lane); S.done(cur); }
#undef PG8_SA
#undef PG8_SB
#undef PG8_STAGE
#undef PG8_LDA
#undef PG8_LDB
#undef PG8_MMA
#undef PG8_WAIT_V
#undef PG8_WAIT_L
#undef PG8_BAR
#undef PG8_SCHED
}
}
namespace att {
using bf16 = __hip_bfloat16;
constexpr int   D = 128, NW = 8, QBLK = 32, KVBLK = 64;
constexpr float SCALE = 0.088388347648318440f;
constexpr float THR = 8.f;
constexpr int SDEPTH = 1;
constexpr size_t SHM_V = KVBLK * D * 2, SHM_K = KVBLK * D * 2, SHM_ATTN = 3 * SHM_V + 3 * SHM_K + NW * 64 * 4;
using bf16x8 = __attribute__((ext_vector_type(8))) short;
using s16x4  = __attribute__((ext_vector_type(4))) short;
using f32x16 = __attribute__((ext_vector_type(16))) float;
using f32x8  = __attribute__((ext_vector_type(8))) float;
using u32x4  = __attribute__((ext_vector_type(4))) unsigned;
#define KSWZ(row, colB) ((row) * 256 + ((colB) ^ (((row) & 7) << 4)))
#define SBAR() __builtin_amdgcn_sched_barrier(0)
__device__ __forceinline__ int crow(int r, int hi) { return (r & 3) + 8 * (r >> 2) + 4 * hi; }
__device__ __forceinline__ unsigned cvtpk(float lo, float hi) {
  unsigned r; asm volatile("v_cvt_pk_bf16_f32 %0, %1, %2" : "=v"(r) : "v"(lo), "v"(hi)); return r;
}
template <typename TIn> struct Stage;
template <> struct Stage<bf16>  { using T = bf16x8;
  __device__ static __forceinline__ T ld8(const bf16* p) { return *reinterpret_cast<const bf16x8*>(p); }
  __device__ static __forceinline__ bf16x8 tobf(T x) { return x; } };
template <> struct Stage<float> { using T = f32x8;
  __device__ static __forceinline__ T ld8(const float* p) { return *reinterpret_cast<const f32x8*>(p); }
  __device__ static __forceinline__ bf16x8 tobf(T x) {
    u32x4 w = {cvtpk(x[0], x[1]), cvtpk(x[2], x[3]), cvtpk(x[4], x[5]), cvtpk(x[6], x[7])}; return *reinterpret_cast<bf16x8*>(&w); } };

__device__ __forceinline__ void partialSM(f32x16& p0, f32x16& p1, float& m_reg, f32x16& negm, float& alpha) {
  constexpr float THRL = THR * 1.4426950408889634f;
  float pmax = p0[0]; for (int r = 1; r < 16; ++r) pmax = fmaxf(pmax, p0[r]); for (int r = 0; r < 16; ++r) pmax = fmaxf(pmax, p1[r]);
  { auto rr = __builtin_amdgcn_permlane32_swap(__float_as_uint(pmax), __float_as_uint(pmax), false, false);
    pmax = fmaxf(__uint_as_float(rr[0]), __uint_as_float(rr[1])); }
  if (__builtin_expect(__all(pmax <= THRL), 1)) { alpha = 1.f; }
  else { const float dl = fmaxf(pmax, 0.f); m_reg += dl; alpha = __builtin_amdgcn_exp2f(-dl);
    for (int r = 0; r < 16; ++r) { p0[r] -= dl; p1[r] -= dl; }
    const float nm = -m_reg; for (int r = 0; r < 16; ++r) negm[r] = nm; }
  for (int r = 0; r < 16; ++r) p0[r] = __builtin_amdgcn_exp2f(p0[r]);
}
__device__ __forceinline__ void finishSM(f32x16& p0, f32x16& p1, float alpha, float& l_reg, bf16x8& pa0, bf16x8& pa1, bf16x8& pa2, bf16x8& pa3) {
  for (int r = 0; r < 16; ++r) p1[r] = __builtin_amdgcn_exp2f(p1[r]);
  float ps = 0; for (int r = 0; r < 16; ++r) ps += p0[r]; for (int r = 0; r < 16; ++r) ps += p1[r];
  { auto rr = __builtin_amdgcn_permlane32_swap(__float_as_uint(ps), __float_as_uint(ps), false, false);
    ps = __uint_as_float(rr[0]) + __uint_as_float(rr[1]); }
  l_reg = l_reg * alpha + ps;
#define PK4(P, BASE, OUT) do { unsigned a0 = cvtpk(P[BASE + 0], P[BASE + 1]), a1 = cvtpk(P[BASE + 2], P[BASE + 3]);   \
    unsigned b0 = cvtpk(P[BASE + 4], P[BASE + 5]), b1 = cvtpk(P[BASE + 6], P[BASE + 7]);                              \
    auto r0 = __builtin_amdgcn_permlane32_swap(a0, b0, false, false); auto r1 = __builtin_amdgcn_permlane32_swap(a1, b1, false, false); \
    u32x4 w = {r0[0], r1[0], r0[1], r1[1]}; OUT = *reinterpret_cast<bf16x8*>(&w); } while (0)
  PK4(p0, 0, pa0); PK4(p0, 8, pa1); PK4(p1, 0, pa2); PK4(p1, 8, pa3);
#undef PK4
}
__device__ __forceinline__ void qkt(f32x16& p0, f32x16& p1, const bf16* Ks, const bf16x8* qr, const f32x16& negm, int r32, int hi) {
#pragma unroll
  for (int d0 = 0; d0 < 8; ++d0) { int cb = (d0 * 16 + hi * 8) * 2;
    bf16x8 b0 = *reinterpret_cast<const bf16x8*>((const char*)Ks + KSWZ(r32, cb));
    bf16x8 b1 = *reinterpret_cast<const bf16x8*>((const char*)Ks + KSWZ(32 + r32, cb));
    if (d0 == 0) { p0 = __builtin_amdgcn_mfma_f32_32x32x16_bf16(b0, qr[0], negm, 0, 0, 0); p1 = __builtin_amdgcn_mfma_f32_32x32x16_bf16(b1, qr[0], negm, 0, 0, 0); }
    else { p0 = __builtin_amdgcn_mfma_f32_32x32x16_bf16(b0, qr[d0], p0, 0, 0, 0); p1 = __builtin_amdgcn_mfma_f32_32x32x16_bf16(b1, qr[d0], p1, 0, 0, 0); } }
}
__device__ __forceinline__ int v_st(int k, int c) { const int kk = (k & ~0xC) | ((k & 4) << 1) | ((k & 8) >> 1); return ((kk >> 3) * 4 + (c >> 5)) * 512 + ((kk & 7) * 32 + (c & 31)) * 2; }
__device__ __forceinline__ int v_rd_base(int lane) { return ((lane & 3) << 3) | (((lane >> 2) & 3) << 6) | (((lane >> 4) & 1) << 5) | (((lane >> 5) & 1) << 8); }
constexpr int v_rd_off(int d0, int ks, int half) { return d0 * 512 + ks * 4096 + half * 2048; }
template <int OFF> __device__ __forceinline__ s16x4 tr_read(int vb) {
  s16x4 r; asm volatile("ds_read_b64_tr_b16 %0, %1 offset:%2" : "=&v"(r) : "v"(vb), "i"(OFF) : "memory"); return r;
}
template <int D0> __device__ __forceinline__ void pv_one(f32x16& od, int vb, bf16x8 pa0, bf16x8 pa1, bf16x8 pa2, bf16x8 pa3) {
  const s16x4 l0 = tr_read<v_rd_off(D0, 0, 0)>(vb), h0 = tr_read<v_rd_off(D0, 0, 1)>(vb), l1 = tr_read<v_rd_off(D0, 1, 0)>(vb), h1 = tr_read<v_rd_off(D0, 1, 1)>(vb);
  const s16x4 l2 = tr_read<v_rd_off(D0, 2, 0)>(vb), h2 = tr_read<v_rd_off(D0, 2, 1)>(vb), l3 = tr_read<v_rd_off(D0, 3, 0)>(vb), h3 = tr_read<v_rd_off(D0, 3, 1)>(vb);
  asm volatile("s_waitcnt lgkmcnt(0)" ::: "memory"); SBAR();
#define PK(L, H) (bf16x8){L[0], L[1], L[2], L[3], H[0], H[1], H[2], H[3]}
  od = __builtin_amdgcn_mfma_f32_32x32x16_bf16(pa0, PK(l0, h0), od, 0, 0, 0);
  od = __builtin_amdgcn_mfma_f32_32x32x16_bf16(pa1, PK(l1, h1), od, 0, 0, 0);
  od = __builtin_amdgcn_mfma_f32_32x32x16_bf16(pa2, PK(l2, h2), od, 0, 0, 0);
  od = __builtin_amdgcn_mfma_f32_32x32x16_bf16(pa3, PK(l3, h3), od, 0, 0, 0);
#undef PK
}
__device__ __forceinline__ void pv_d0(f32x16* o, int vb, bf16x8 pa0, bf16x8 pa1, bf16x8 pa2, bf16x8 pa3) {
  pv_one<0>(o[0], vb, pa0, pa1, pa2, pa3); pv_one<1>(o[1], vb, pa0, pa1, pa2, pa3); pv_one<2>(o[2], vb, pa0, pa1, pa2, pa3); pv_one<3>(o[3], vb, pa0, pa1, pa2, pa3);
}
template <int LDQ, int LDK, int LDO>
__device__ __forceinline__ void attn_dense_body(const bf16* __restrict__ Qb, const bf16* __restrict__ Kh, const bf16* __restrict__ Vh,
                                                bf16* __restrict__ Ob, int seq, char* lds) {
  using TQ = bf16;
  using St = Stage<bf16>; using SQ = Stage<TQ>;
  const int tid = fresh_tid(), wid = tid >> 6, lane = tid & 63, r32 = lane & 31, hi = lane >> 5;
  bf16* V_lds = (bf16*)lds; bf16* K_lds = (bf16*)(lds + 3 * SHM_V);
  float* ws = (float*)(lds + 3 * SHM_V + 3 * SHM_K) + wid * 64; float* li_l = ws; float* al_l = ws + 32;
  float m_reg = 0.f, l_reg = 0; f32x16 o[4] = {}; bf16x8 qr[8]; f32x16 negm = {}; asm volatile("" : "+v"(negm));
  const TQ* Qw = Qb + (long)(wid * QBLK + r32) * LDQ + hi * 8;
#pragma unroll
  for (int d0 = 0; d0 < 8; ++d0) qr[d0] = SQ::tobf(SQ::ld8(Qw + d0 * 16));
  const int sr = tid >> 4, sc = (tid & 15) * 8, vst0 = v_st(sr, sc), vst1 = v_st(32 + sr, sc);
  const int vb0 = (int)(uintptr_t)V_lds + v_rd_base(lane);
  struct { typename St::T vs0, vs1, ks0, ks1; } sr_[SDEPTH];
#define SLOAD(i, k0) do { sr_[i].vs0 = St::ld8(&Vh[(long)((k0) + sr) * LDK + sc]); sr_[i].vs1 = St::ld8(&Vh[(long)((k0) + 32 + sr) * LDK + sc]); \
    sr_[i].ks0 = St::ld8(&Kh[(long)((k0) + sr) * LDK + sc]); sr_[i].ks1 = St::ld8(&Kh[(long)((k0) + 32 + sr) * LDK + sc]); } while (0)
#define SWRITE(off, i) do { *(bf16x8*)((char*)V_lds + (off) + vst0) = St::tobf(sr_[i].vs0);          \
    *(bf16x8*)((char*)V_lds + (off) + vst1) = St::tobf(sr_[i].vs1); int kc = sc * 2;               \
    *(bf16x8*)((char*)K_lds + (off) + KSWZ(sr, kc)) = St::tobf(sr_[i].ks0);                       \
    *(bf16x8*)((char*)K_lds + (off) + KSWZ(32 + sr, kc)) = St::tobf(sr_[i].ks1); } while (0)
#define SWAIT() do { if constexpr (SDEPTH == 2) asm volatile("s_waitcnt vmcnt(4)" ::: "memory"); else asm volatile("s_waitcnt vmcnt(0)" ::: "memory"); } while (0)
#define RESC(a) do { if (__any((a) < 1.f)) { if (hi == 0) al_l[r32] = (a); asm volatile("s_waitcnt lgkmcnt(0)" ::: "memory"); \
    for (int d = 0; d < 4; ++d) for (int r = 0; r < 16; ++r) o[d][r] *= al_l[crow(r, hi)]; } } while (0)
  f32x16 pA0, pA1, pB0, pB1; float alA, alB; bf16x8 pa0, pa1, pa2, pa3; const int NT = seq / KVBLK;
  constexpr int SE = 0, SO = SDEPTH - 1;
  SLOAD(SE, 0); asm volatile("s_waitcnt vmcnt(0)" ::: "memory"); SWRITE(0, SE); __syncthreads();
  qkt(pA0, pA1, K_lds, qr, negm, r32, hi); partialSM(pA0, pA1, m_reg, negm, alA);
  SLOAD(SO, KVBLK); if constexpr (SDEPTH == 2) { if (2 < NT) SLOAD(SE, 2 * KVBLK); }
  SWAIT(); SWRITE((int)SHM_V, SO); __syncthreads();
  int o_prv = 0, o_cur = (int)SHM_V, o_nxt = 2 * (int)SHM_V;
  if (wid >= 4) __builtin_amdgcn_s_setprio(1);
#define ROT3() do { const int t_ = o_prv; o_prv = o_cur; o_cur = o_nxt; o_nxt = t_; } while (0)
  for (int j = 1; j + 1 < NT; j += 2) {
    SBAR(); qkt(pB0, pB1, (bf16*)((char*)K_lds + o_cur), qr, negm, r32, hi);
    finishSM(pA0, pA1, alA, l_reg, pa0, pa1, pa2, pa3); SBAR();
    SLOAD(SO, (j + SDEPTH) * KVBLK); SBAR();
    pv_d0(o, vb0 + o_prv, pa0, pa1, pa2, pa3); partialSM(pB0, pB1, m_reg, negm, alB);
    SWAIT(); SWRITE(o_nxt, SE);
    RESC(alB); __syncthreads(); ROT3();
    SBAR(); qkt(pA0, pA1, (bf16*)((char*)K_lds + o_cur), qr, negm, r32, hi);
    finishSM(pB0, pB1, alB, l_reg, pa0, pa1, pa2, pa3); SBAR();
    if (SDEPTH == 1 || j + 3 < NT) SLOAD(SE, (j + 1 + SDEPTH) * KVBLK); SBAR();
    pv_d0(o, vb0 + o_prv, pa0, pa1, pa2, pa3); partialSM(pA0, pA1, m_reg, negm, alA);
    SWAIT(); SWRITE(o_nxt, SO);
    RESC(alA); __syncthreads(); ROT3();
  }
  SBAR(); qkt(pB0, pB1, (bf16*)((char*)K_lds + o_cur), qr, negm, r32, hi);
  finishSM(pA0, pA1, alA, l_reg, pa0, pa1, pa2, pa3); SBAR();
  pv_d0(o, vb0 + o_prv, pa0, pa1, pa2, pa3); partialSM(pB0, pB1, m_reg, negm, alB);
  RESC(alB);
  finishSM(pB0, pB1, alB, l_reg, pa0, pa1, pa2, pa3); SBAR();
  pv_d0(o, vb0 + o_cur, pa0, pa1, pa2, pa3);
  __builtin_amdgcn_s_setprio(0);
#undef ROT3
  if (hi == 0) li_l[r32] = l_reg; asm volatile("s_waitcnt lgkmcnt(0)" ::: "memory");
  float rli[16];
#pragma unroll
  for (int r = 0; r < 16; ++r) rli[r] = __builtin_amdgcn_rcpf(li_l[crow(r, hi)]);
  bf16* Ow = Ob + (long)(wid * QBLK) * LDO;
#pragma unroll
  for (int r = 0; r < 16; ++r) { int orow = crow(r, hi);
    for (int d0 = 0; d0 < 4; ++d0) Ow[(long)orow * LDO + d0 * 32 + r32] = __float2bfloat16(o[d0][r] * rli[r]); }
#undef SLOAD
#undef SWRITE
#undef SWAIT
#undef RESC
  __syncthreads();
}
#undef KSWZ
#undef SBAR
}
struct Args { const float* in[17]; float* out; unsigned char* ws; };

typedef const __attribute__((address_space(4))) Args* KArgs;
__device__ __forceinline__ KArgs kargs() { KArgs p = (KArgs)__builtin_amdgcn_kernarg_segment_ptr(); asm volatile("" : "+s"(p)); return p; }
struct Frame {
    LAS unsigned char* lds;
    int tid, lane, wave, vcu, G, gw, NGW;
    __device__ __forceinline__ void init(unsigned char* lds_) {
        lds = (LAS unsigned char*)lds_;
        tid = fresh_tid(); lane = tid & 63; wave = __builtin_amdgcn_readfirstlane(tid >> 6);
        G = gridDim.x; { const int bx = fresh_bid(); vcu = (G % 8 == 0) ? (bx % 8) * (G / 8) + bx / 8 : bx; }
        gw = vcu * NWAVES + wave; NGW = G * NWAVES;
    }
};
#define FIN(i) (ka->in[i])
#define FWS (ka->ws)

#define XB_TMO      128
#define XB_XCNT(j)  (256  + 64 * (j))
#define XB_XSUB(j)  (1280 + 64 * (j))
#define XB_XGEN(j)  (2304 + 64 * (j))
#define XB_TOP      3328
#define XB_TOPGEN   3392
#define XCD_BAR_WORDS 3456
#define XB_SPIN_CAP (1u << 18)

__device__ __forceinline__ unsigned xb_ld(unsigned* p)              { return __hip_atomic_load(p, __ATOMIC_RELAXED, __HIP_MEMORY_SCOPE_AGENT); }
__device__ __forceinline__ unsigned xb_add(unsigned* p, unsigned v) { return __hip_atomic_fetch_add(p, v, __ATOMIC_RELAXED, __HIP_MEMORY_SCOPE_AGENT); }
__device__ __forceinline__ unsigned xb_xcc_id() { return (unsigned)__builtin_amdgcn_s_getreg((3 << 11) | 20) & 0xFu; }
#define XB_SPIN(cond, bar) do { unsigned _sp = 0; while (cond) { __builtin_amdgcn_s_sleep(1); \
    if ((++_sp & 255u) == 0u) { if (xb_ld(&(bar)[XB_TMO])) break; if (_sp > XB_SPIN_CAP) { atomicAdd(&(bar)[XB_TMO], 1u); break; } } } } while (0)

struct XcdBarrier {
    unsigned* bar; unsigned x;
    volatile LAS unsigned* st;
};

__device__ __forceinline__ XcdBarrier xcd_barrier_post(unsigned* bar, volatile LAS unsigned* st) {
    XcdBarrier b; b.bar = bar; b.x = xb_xcc_id(); b.st = st;
    if (threadIdx.x == 0) (void)xb_add(&bar[XB_XCNT(b.x)], 1u);
    return b;
}
__device__ __forceinline__ void xcd_barrier_complete(unsigned* bar, unsigned x, unsigned& nloc, unsigned& nx) {
    const unsigned G = gridDim.x * gridDim.y * gridDim.z;
    unsigned sum, cnt, mine, sp = 0u;
    for (;;) {
        sum = 0u; cnt = 0u; mine = 0u;
#pragma unroll
        for (unsigned j = 0; j < 16; ++j) { const unsigned c = xb_ld(&bar[XB_XCNT(j)]); sum += c; cnt += (c > 0u) ? 1u : 0u; mine = (j == x) ? c : mine; }
        if (sum == G) break;
        __builtin_amdgcn_s_sleep(1);
        if ((++sp & 255u) == 0u) { if (xb_ld(&bar[XB_TMO])) break; if (sp > XB_SPIN_CAP) { atomicAdd(&bar[XB_TMO], 1u); break; } }
    }
    nloc = mine > 0u ? mine : 1u; nx = cnt > 0u ? cnt : 1u;
}

__device__ __forceinline__ void xcd_barrier(const XcdBarrier& b) {
    asm volatile("s_waitcnt vmcnt(0)" ::: "memory");
    __syncthreads();
    if (threadIdx.x == 0) {
        unsigned* bar = b.bar;
        __builtin_amdgcn_s_waitcnt(0);
        unsigned nloc = b.st[0], nx = b.st[1];
        if (nloc == 0u) { xcd_barrier_complete(bar, b.x, nloc, nx); b.st[0] = nloc; b.st[1] = nx; }
        const unsigned old = xb_add(&bar[XB_XSUB(b.x)], 1u);
        const unsigned gen = old / nloc;
        if (old + 1u == (gen + 1u) * nloc) {
            __builtin_amdgcn_fence(__ATOMIC_RELEASE, "agent");
            asm volatile("s_waitcnt vmcnt(0)" ::: "memory");
            const unsigned og = xb_add(&bar[XB_TOP], 1u);
            const unsigned tg = og / nx;
            if (og + 1u == (tg + 1u) * nx) xb_add(&bar[XB_TOPGEN], 1u);
            else XB_SPIN(xb_ld(&bar[XB_TOPGEN]) == tg, bar);
            __builtin_amdgcn_fence(__ATOMIC_ACQUIRE, "agent");
            xb_add(&bar[XB_XGEN(b.x)], 1u);
            asm volatile("s_waitcnt vmcnt(0)" ::: "memory");
        } else {
            XB_SPIN(xb_ld(&bar[XB_XGEN(b.x)]) == gen, bar);
            __builtin_amdgcn_fence(__ATOMIC_ACQUIRE, "agent");
            asm volatile("s_waitcnt vmcnt(0)" ::: "memory");
        }
    }
    __syncthreads();
}

constexpr int XB_LDS_OFF = RING_BYTES + 64;
constexpr int XB_WORD0 = 1024;
__device__ __forceinline__ void grid_bar(unsigned char* lds_) {
    KArgs ka = kargs();
    XcdBarrier b; b.bar = (unsigned*)(ka->ws + WS_CTL) + XB_WORD0; b.x = xb_xcc_id(); b.st = (volatile LAS unsigned*)((LAS unsigned char*)lds_ + XB_LDS_OFF);
    xcd_barrier(b);
}

__device__ __forceinline__ void p0_transpose_item(const float* W, int K, int N, bf16raw* WT, LAS float* scr, int kb, int nb, int lane) {
    const int k0 = 64 * kb, n0 = 32 * nb;
#pragma unroll 8
    for (int i = 0; i < 32; ++i) { const int kk = 2 * i + (lane >> 5); scr[kk * 33 + (lane & 31)] = W[(size_t)(k0 + kk) * N + n0 + (lane & 31)]; }
    asm volatile("s_waitcnt lgkmcnt(0)" ::: "memory");
    const int c = lane & 7;
#pragma unroll
    for (int j = 0; j < 4; ++j) { const int n = (lane >> 3) + 8 * j; const LAS float* s = scr + (8 * c) * 33 + n;
        v4u o; o.x = pk2(s[0 * 33], s[1 * 33]); o.y = pk2(s[2 * 33], s[3 * 33]); o.z = pk2(s[4 * 33], s[5 * 33]); o.w = pk2(s[6 * 33], s[7 * 33]);
        *(v4u*)(WT + (size_t)(n0 + n) * K + k0 + 8 * c) = o; }
    asm volatile("s_waitcnt lgkmcnt(0)" ::: "memory");
}
__device__ __forceinline__ void p0_fold_item(const float* wpool, const float* ps, const float* wout, bf16raw* WT, int it, int lane) {
    const int nb = it & 63, ct = it >> 6, g = ct >> 3, c0 = (ct & 7) * 16, n = nb * 32 + (lane & 31), ch = lane >> 5;
    const float* wp = wpool + ((size_t)g * 128 + c0 + ch * 8) * 128;
    const float* wo = wout + (size_t)(1024 + g * 128) * 2048 + n;
    const float* psg = ps + g * 128;
    float acc[8];
#pragma unroll
    for (int i = 0; i < 8; ++i) acc[i] = 0.f;
#pragma unroll 2
    for (int e4 = 0; e4 < 32; ++e4) {
        const v4f pv = *(const v4f*)(psg + 4 * e4);
        const float w0 = wo[(size_t)(4 * e4 + 0) * 2048] * pv.x, w1 = wo[(size_t)(4 * e4 + 1) * 2048] * pv.y, w2 = wo[(size_t)(4 * e4 + 2) * 2048] * pv.z, w3 = wo[(size_t)(4 * e4 + 3) * 2048] * pv.w;
#pragma unroll
        for (int i = 0; i < 8; ++i) { const v4f p = *(const v4f*)(wp + i * 128 + 4 * e4); acc[i] += p.x * w0 + p.y * w1 + p.z * w2 + p.w * w3; }
    }
    *(v4u*)(WT + (size_t)n * 2048 + 1024 + g * 128 + c0 + ch * 8) = pack8(acc);
}

__device__ __forceinline__ void p0_prologue(unsigned char* lds_) {
    KArgs ka = kargs(); Frame F; F.init(lds_);
    LAS float* ACT = (LAS float*)F.lds;
    LAS float* PART = (LAS float*)(F.lds + 32768);
    for (int idx = F.tid; idx < 3 * 2048; idx += NTHREADS) { const int s = idx >> 11, d = idx & 2047; const float v = s < 2 ? FIN(1)[s * 2048 + d] : FIN(3)[d]; ACT[idx] = v / (1.f + expf(-v)); }
    __syncthreads();
    float* mod = (float*)(FWS + WS_MOD);
    for (int item = blockIdx.x; item < 256; item += F.G) {
        const int col0 = item * 96, l = col0 / 12288, cl = col0 % 12288;
        if (F.tid < 504) {
            const int cq = F.tid % 24, rg = F.tid / 24; const float* wp = FIN(4) + (size_t)l * 2048 * 12288 + cl + cq * 4;
            v4f a0 = {0.f, 0.f, 0.f, 0.f}, a1 = a0, a2 = a0;
#pragma unroll 7
            for (int d = rg; d < 2048; d += 21) { const v4f w = *(const v4f*)(wp + (size_t)d * 12288); a0 += w * ACT[d]; a1 += w * ACT[2048 + d]; a2 += w * ACT[4096 + d]; }
            *(LAS v4f*)(PART + (rg * 3 + 0) * 96 + cq * 4) = a0; *(LAS v4f*)(PART + (rg * 3 + 1) * 96 + cq * 4) = a1; *(LAS v4f*)(PART + (rg * 3 + 2) * 96 + cq * 4) = a2;
        }
        __syncthreads();
        if (F.tid < 288) { const int s = F.tid / 96, cc = F.tid % 96; float sum = FIN(5)[l * 12288 + cl + cc];
            for (int rg = 0; rg < 21; ++rg) sum += PART[(rg * 3 + s) * 96 + cc];
            mod[(size_t)(l * 3 + s) * 12288 + cl + cc] = sum; }
        __syncthreads();
    }
    { bf16raw* Xb = (bf16raw*)(FWS + WS_X); const int gt = F.vcu * NTHREADS + F.tid, NT_ = F.G * NTHREADS;
      for (int i = gt; i < NB * CTX * 256; i += NT_) { const int row = i >> 8, c8 = i & 255, b = row >> 8, j = row & 255;
          const v4f a0 = *(const v4f*)(FIN(2) + (size_t)row * 2048 + c8 * 8), a1 = *(const v4f*)(FIN(2) + (size_t)row * 2048 + c8 * 8 + 4);
          v4u w; w.x = pk2(a0.x, a0.y); w.y = pk2(a0.z, a0.w); w.z = pk2(a1.x, a1.y); w.w = pk2(a1.z, a1.w);
          *(v4u*)(Xb + ((size_t)b * RPB + j) * 2048 + c8 * 8) = w; } }
    { float* rope = (float*)(FWS + WS_ROPE); const int gt = F.vcu * NTHREADS + F.tid;
      if (gt < 192 * 32) { const int p = gt >> 5, f = gt & 31; const float inv = powf(10000.0f, -(float)f / 32.0f);
          if (p < 128) { const float ang = (float)p * inv; rope[p * 32 + f] = cosf(ang); rope[4096 + p * 32 + f] = sinf(ang); }
          else { const float ang = (float)(p - 128) * inv; rope[8192 + (p - 128) * 32 + f] = cosf(ang); rope[8192 + 2048 + (p - 128) * 32 + f] = sinf(ang); } } }
    LAS float* scr = (LAS float*)(F.lds + F.wave * 16384);
    constexpr int I_IN = 32 * 112, I_OUT = 24 * 64, I_F1 = 32 * 256, I_F2 = 128 * 64, I_FOLD = 32 * 64, I_L = I_IN + I_OUT + I_F1 + I_F2 + I_FOLD;
    for (int it = F.gw; it < 2 * I_L; it += F.NGW) {
        const int l = it / I_L; int r = it % I_L; unsigned char* wl = FWS + WS_W + (size_t)l * WL_BYTES;
        if (r < I_IN) { p0_transpose_item(FIN(8) + (size_t)l * 2048 * 3584, 2048, 3584, (bf16raw*)(wl + WO_IN), scr, r / 112, r % 112, F.lane); continue; } r -= I_IN;
        if (r < I_OUT) { int kb = r / 64; kb = kb < 16 ? kb : kb + 8; p0_transpose_item(FIN(14) + (size_t)l * 2048 * 2048, 2048, 2048, (bf16raw*)(wl + WO_OUT), scr, kb, r % 64, F.lane); continue; } r -= I_OUT;
        if (r < I_F1) { p0_transpose_item(FIN(15) + (size_t)l * 2048 * 8192, 2048, 8192, (bf16raw*)(wl + WO_FF1), scr, r / 256, r % 256, F.lane); continue; } r -= I_F1;
        if (r < I_F2) { p0_transpose_item(FIN(16) + (size_t)l * 8192 * 2048, 8192, 2048, (bf16raw*)(wl + WO_FF2), scr, r / 64, r % 64, F.lane); continue; } r -= I_F2;
        p0_fold_item(FIN(11) + (size_t)l * 4 * 128 * 128, FIN(12) + (size_t)l * 512, FIN(14) + (size_t)l * 2048 * 2048, (bf16raw*)(wl + WO_OUT), r, F.lane);
    }
}

__device__ __forceinline__ void norm_phase(unsigned char* lds_, int l, int which  , int src_in, int skip_ctx, int nslab, const float* slab, int gate_off, int write_x) {
    KArgs ka = kargs(); Frame F; F.init(lds_);
    LAS float* GS = (LAS float*)F.lds; LAS float* SH = GS + 3 * 2048;
    const float* mod = (const float*)(FWS + WS_MOD) + (size_t)l * 3 * 12288; const float* g = (which == 1 ? FIN(6) : FIN(7)) + l * 2048;
    const int shc = which == 1 ? 0 : 3, scc = shc + 1;
    for (int idx = F.tid; idx < 3 * 2048; idx += NTHREADS) { const int s = idx >> 11, c = idx & 2047; GS[idx] = g[c] * (1.f + mod[s * 12288 + scc * 2048 + c]); SH[idx] = mod[s * 12288 + shc * 2048 + c]; }
    __syncthreads();
    bf16raw* Xb = (bf16raw*)(FWS + WS_X); bf16raw* H = (bf16raw*)(FWS + WS_H);
    const float* mod0 = (const float*)(FWS + WS_MOD);
    constexpr int NR = 4;
    for (int r0 = F.gw; r0 < MROWS; r0 += NR * F.NGW) {
        float v[NR][4][8]; int sidx[NR]; bool act[NR];
#pragma unroll
        for (int q = 0; q < NR; ++q) {
            const int r = r0 + q * F.NGW; const int rr = r < MROWS ? r : r0; const int b = rr / RPB, j = rr % RPB; const bool isctx = j < CTX;
            act[q] = r < MROWS && !(isctx && skip_ctx); sidx[q] = isctx ? 2 : b;
            if (src_in) { const float* xr = isctx ? FIN(2) + ((size_t)b * CTX + j) * 2048 : FIN(0) + ((size_t)b * SEQ + (j - CTX)) * 2048;
#pragma unroll
                for (int jj = 0; jj < 4; ++jj) { const v4f a0 = *(const v4f*)(xr + F.lane * 8 + 512 * jj), a1 = *(const v4f*)(xr + F.lane * 8 + 512 * jj + 4);
                    v[q][jj][0] = a0.x; v[q][jj][1] = a0.y; v[q][jj][2] = a0.z; v[q][jj][3] = a0.w; v[q][jj][4] = a1.x; v[q][jj][5] = a1.y; v[q][jj][6] = a1.z; v[q][jj][7] = a1.w; } }
            else {
#pragma unroll
                for (int jj = 0; jj < 4; ++jj) unpack8(*(const v4u*)(Xb + (size_t)rr * 2048 + F.lane * 8 + 512 * jj), v[q][jj]); }
            if (nslab > 0 && isctx && act[q]) {
                const float* sp = slab + ((size_t)b * CTX + j) * 2048 + F.lane * 8; const float* gp = mod0 + gate_off + F.lane * 8;
                v4f sacc[4][2];
#pragma unroll
                for (int jj = 0; jj < 4; ++jj) { sacc[jj][0] = (v4f){0.f, 0.f, 0.f, 0.f}; sacc[jj][1] = sacc[jj][0]; }
#pragma unroll 2
                for (int k = 0; k < nslab; ++k) {
#pragma unroll
                    for (int jj = 0; jj < 4; ++jj) { sacc[jj][0] += *(const v4f*)(sp + (size_t)k * 512 * 2048 + 512 * jj); sacc[jj][1] += *(const v4f*)(sp + (size_t)k * 512 * 2048 + 512 * jj + 4); } }
#pragma unroll
                for (int jj = 0; jj < 4; ++jj) { const v4f g0 = *(const v4f*)(gp + 512 * jj), g1 = *(const v4f*)(gp + 512 * jj + 4);
                    v[q][jj][0] += g0.x * sacc[jj][0].x; v[q][jj][1] += g0.y * sacc[jj][0].y; v[q][jj][2] += g0.z * sacc[jj][0].z; v[q][jj][3] += g0.w * sacc[jj][0].w;
                    v[q][jj][4] += g1.x * sacc[jj][1].x; v[q][jj][5] += g1.y * sacc[jj][1].y; v[q][jj][6] += g1.z * sacc[jj][1].z; v[q][jj][7] += g1.w * sacc[jj][1].w;
                    if (write_x) *(v4u*)(Xb + (size_t)rr * 2048 + F.lane * 8 + 512 * jj) = pack8(v[q][jj]); }
            }
        }
#pragma unroll
        for (int q = 0; q < NR; ++q) {
            float ss = 0.f;
#pragma unroll
            for (int jj = 0; jj < 4; ++jj)
#pragma unroll
                for (int i = 0; i < 8; ++i) ss += v[q][jj][i] * v[q][jj][i];
            const float rstd = 1.f / sqrtf(wave_sum(ss) * (1.f / 2048.f) + EPS);
            if (act[q]) { bf16raw* hr = H + (size_t)(r0 + q * F.NGW) * 2048; const int s = sidx[q];
#pragma unroll
                for (int jj = 0; jj < 4; ++jj) { const int c = F.lane * 8 + 512 * jj;
                    const v4f g0 = *(const LAS v4f*)(GS + s * 2048 + c), g1 = *(const LAS v4f*)(GS + s * 2048 + c + 4), h0 = *(const LAS v4f*)(SH + s * 2048 + c), h1 = *(const LAS v4f*)(SH + s * 2048 + c + 4);
                    float o[8]; o[0] = v[q][jj][0] * rstd * g0.x + h0.x; o[1] = v[q][jj][1] * rstd * g0.y + h0.y; o[2] = v[q][jj][2] * rstd * g0.z + h0.z; o[3] = v[q][jj][3] * rstd * g0.w + h0.w;
                    o[4] = v[q][jj][4] * rstd * g1.x + h1.x; o[5] = v[q][jj][5] * rstd * g1.y + h1.y; o[6] = v[q][jj][6] * rstd * g1.z + h1.z; o[7] = v[q][jj][7] * rstd * g1.w + h1.w;
                    *(v4u*)(hr + c) = pack8(o); } }
        }
    }
    __syncthreads();
}

constexpr float QSCALE = 0.088388347648318440f * 1.4426950408889634f;
struct RopeCS { v4f c0, c1, s0, s1; };
__device__ __forceinline__ void normrope8(float* x, const v4f g0, const v4f g1, const RopeCS& rc, bool dorope, int lane) {
    const int sub = lane & 15, quarter = sub >> 2;
    float ss = 0.f;
#pragma unroll
    for (int i = 0; i < 8; ++i) ss += x[i] * x[i];
    ss += __shfl_xor(ss, 1); ss += __shfl_xor(ss, 2); ss += __shfl_xor(ss, 4); ss += __shfl_xor(ss, 8);
    const float rstd = 1.f / sqrtf(ss * (1.f / 128.f) + EPS);
    x[0] *= rstd * g0.x; x[1] *= rstd * g0.y; x[2] *= rstd * g0.z; x[3] *= rstd * g0.w; x[4] *= rstd * g1.x; x[5] *= rstd * g1.y; x[6] *= rstd * g1.z; x[7] *= rstd * g1.w;
    float p[8];
#pragma unroll
    for (int i = 0; i < 8; ++i) p[i] = __shfl_xor(x[i], 4);
    if (dorope) {
        const float cs[8] = {rc.c0.x, rc.c0.y, rc.c0.z, rc.c0.w, rc.c1.x, rc.c1.y, rc.c1.z, rc.c1.w}, sn[8] = {rc.s0.x, rc.s0.y, rc.s0.z, rc.s0.w, rc.s1.x, rc.s1.y, rc.s1.z, rc.s1.w};
        const float sg = (quarter & 1) ? 1.f : -1.f;
#pragma unroll
        for (int i = 0; i < 8; ++i) x[i] = x[i] * cs[i] + sg * p[i] * sn[i];
    }
}
__device__ __forceinline__ void a2_phase(unsigned char* lds_, int l, int last) {
    KArgs ka = kargs(); Frame F; F.init(lds_);
    bf16raw* P = (bf16raw*)(FWS + WS_P); bf16raw* CAT = (bf16raw*)(FWS + WS_CAT); bf16raw* KV = (bf16raw*)(FWS + WS_KV); bf16raw* QN = (bf16raw*)(FWS + WS_QN);
    const float* rope = (const float*)(FWS + WS_ROPE);
    const int lane = F.lane, sub = lane & 15, quarter = sub >> 2, f0 = (sub & 3) * 8;
    const v4f qg0 = *(const v4f*)(FIN(9) + l * 128 + sub * 8), qg1 = *(const v4f*)(FIN(9) + l * 128 + sub * 8 + 4);
    const v4f kg0 = *(const v4f*)(FIN(10) + l * 128 + sub * 8), kg1 = *(const v4f*)(FIN(10) + l * 128 + sub * 8 + 4);
    const float* cw = FIN(13) + (size_t)l * 3 * 512 + lane * 8;
    v4f cwv[3][2];
#pragma unroll
    for (int jj = 0; jj < 3; ++jj) { cwv[jj][0] = *(const v4f*)(cw + jj * 512); cwv[jj][1] = *(const v4f*)(cw + jj * 512 + 4); }
    const int gi = lane >> 4, lo = 1 << gi;
    for (int r = F.gw; r < MROWS; r += F.NGW) {
        const int b = r / RPB, j = r % RPB; const bool isctx = j < CTX; const int pos = j - CTX, prow = isctx ? 0 : pos >> 6, pcol = isctx ? 0 : pos & 63;
        const int t = isctx ? j : pos, n = isctx ? CTX : SEQ; const bool full = !(isctx && last);
        bf16raw* Pr = P + (size_t)r * INW;
        const v4u kvraw = *(const v4u*)(Pr + K_OFF + lane * 8);
        RopeCS rc;
        { const int co = quarter < 2 ? prow * 32 + f0 : 8192 + pcol * 32 + f0, so = co + (quarter < 2 ? 4096 : 2048);
          rc.c0 = *(const v4f*)(rope + co); rc.c1 = *(const v4f*)(rope + co + 4); rc.s0 = *(const v4f*)(rope + so); rc.s1 = *(const v4f*)(rope + so + 4); }
        if (full) {
            const v4u q0 = *(const v4u*)(Pr + lane * 8), q1 = *(const v4u*)(Pr + 512 + lane * 8);
            v4u pw[16];
            const bf16raw* pb = P + (size_t)(r - t) * INW + POOL_OFF + lane * 8;
#pragma unroll
            for (int d = 0; d < 16; ++d) { int tt = t - 8 + d; tt = tt < 0 ? 0 : (tt > n - 1 ? n - 1 : tt); pw[d] = *(const v4u*)(pb + (size_t)tt * INW); }
            const v4u cbr = *(const v4u*)(Pr + CB_OFF + lane * 8);
            v4u ccr[3], cvr[3];
#pragma unroll
            for (int jj = 0; jj < 3; ++jj) { int tt = t + jj - 1; tt = tt < 0 ? 0 : (tt > n - 1 ? n - 1 : tt); const bf16raw* p2 = P + (size_t)(r - t + tt) * INW + lane * 8; ccr[jj] = *(const v4u*)(p2 + CC_OFF); cvr[jj] = *(const v4u*)(p2 + CV_OFF); }
            { float x[8]; unpack8(q0, x); normrope8(x, qg0, qg1, rc, !isctx, lane);
#pragma unroll
              for (int i = 0; i < 8; ++i) x[i] *= QSCALE;
              *(v4u*)(QN + (size_t)r * 1024 + lane * 8) = pack8(x); }
            { float x[8]; unpack8(q1, x); normrope8(x, qg0, qg1, rc, !isctx, lane);
#pragma unroll
              for (int i = 0; i < 8; ++i) x[i] *= QSCALE;
              *(v4u*)(QN + (size_t)r * 1024 + 512 + lane * 8) = pack8(x); }
            { float acc[8], me[8];
#pragma unroll
              for (int i = 0; i < 8; ++i) acc[i] = 0.f;
              int cnt = 0;
#pragma unroll
              for (int d = 0; d < 16; ++d) { const int dt = d - 8, tt = t + dt; const bool ok = dt >= -lo && dt < lo && tt >= 0 && tt < n; float x[8]; unpack8(pw[d], x); const float m = ok ? 1.f : 0.f; cnt += ok ? 1 : 0;
#pragma unroll
                  for (int i = 0; i < 8; ++i) acc[i] += m * x[i]; }
              unpack8(pw[8], me); const float ic = 1.f / (float)cnt;
#pragma unroll
              for (int i = 0; i < 8; ++i) acc[i] = acc[i] * ic - me[i];
              *(v4u*)(CAT + (size_t)r * 2048 + 1024 + lane * 8) = pack8(acc); }
            { float cb[8], acc[8]; unpack8(cbr, cb);
#pragma unroll
              for (int i = 0; i < 8; ++i) acc[i] = 0.f;
#pragma unroll
              for (int jj = 0; jj < 3; ++jj) { const int tt = t + jj - 1; const float m = (tt >= 0 && tt < n) ? 1.f : 0.f; float a[8], v[8]; unpack8(ccr[jj], a); unpack8(cvr[jj], v);
                  const float ww[8] = {cwv[jj][0].x, cwv[jj][0].y, cwv[jj][0].z, cwv[jj][0].w, cwv[jj][1].x, cwv[jj][1].y, cwv[jj][1].z, cwv[jj][1].w};
#pragma unroll
                  for (int i = 0; i < 8; ++i) acc[i] += m * a[i] * v[i] * ww[i]; }
#pragma unroll
              for (int i = 0; i < 8; ++i) acc[i] *= cb[i];
              *(v4u*)(CAT + (size_t)r * 2048 + 1536 + lane * 8) = pack8(acc); }
        }
        { float x[8]; unpack8(kvraw, x); normrope8(x, kg0, kg1, rc, !isctx, lane); const v4u kn = pack8(x); const int hd = (lane >> 4) & 1;
          bf16raw* dst = KV + (lane < 32 ? (size_t)0 : (size_t)NB * 2 * RPB * 128) + ((size_t)(b * 2 + hd) * RPB + j) * 128 + sub * 8; *(v4u*)dst = lane < 32 ? kn : kvraw; }
    }
}

__device__ __forceinline__ void attn_phase(unsigned char* lds_, int last) {
    KArgs ka = kargs(); Frame F; F.init(lds_); char* lds = (char*)lds_;
    const att::bf16* QN = (const att::bf16*)(FWS + WS_QN); const att::bf16* KV = (const att::bf16*)(FWS + WS_KV); att::bf16* CAT = (att::bf16*)(FWS + WS_CAT);
    const int nlat = 512, nctx = last ? 0 : 16;
    for (int i = 0;; ++i) {
        const int idx = i * F.G + F.vcu; if (idx >= nlat + nctx) break;
        int b, h, qrow, seq;
        if (idx < nlat) { const int per = F.G >= 4 ? F.G / 4 : 1; int u;
            if (F.G == 256) { const int combo = F.vcu / per, k = F.vcu % per; u = combo * 128 + k + i * per; } else u = idx;
            const int combo = u >> 7, w = u & 127; b = combo >> 1; h = (combo & 1) * 4 + (w >> 5); qrow = b * RPB + CTX + (w & 31) * 256; seq = RPB; }
        else { const int e = idx - nlat; b = e >> 3; h = e & 7; qrow = b * RPB; seq = CTX; }
        const int kvh = h >> 2;
        att::attn_dense_body<1024, 128, 2048>(QN + (size_t)qrow * 1024 + h * 128, KV + (size_t)(b * 2 + kvh) * RPB * 128, KV + (size_t)NB * 2 * RPB * 128 + (size_t)(b * 2 + kvh) * RPB * 128,
                                             CAT + (size_t)qrow * 2048 + h * 128, seq, lds);
    }
}

#ifndef REP_PREP
#define REP_PREP 1
#endif
#ifndef REP_NORM
#define REP_NORM 1
#endif
#ifndef REP_ATTN
#define REP_ATTN 1
#endif
#ifndef REP_INPROJ
#define REP_INPROJ 1
#endif
#ifndef SPLITK_CTX
#define SPLITK_CTX 1
#endif
#ifndef REP_A2
#define REP_A2 1
#endif
#ifndef REP_BAR
#define REP_BAR 0
#endif
#ifndef REP_OUTPROJ
#define REP_OUTPROJ 1
#endif
#ifndef REP_FF2
#define REP_FF2 1
#endif
#ifndef REP_FF1
#define REP_FF1 1
#endif
__global__ void __launch_bounds__(NTHREADS, 2) fwd_megakernel(Args args) {
    extern __shared__ __attribute__((aligned(16))) unsigned char lds[];
    cg::grid_group grid = cg::this_grid();
    if (threadIdx.x < 2) ((LAS unsigned*)((LAS unsigned char*)lds + XB_LDS_OFF))[threadIdx.x] = 0u;
    __syncthreads();
    if (blockIdx.x == 0) { KArgs ka = kargs(); unsigned* bw = (unsigned*)(ka->ws + WS_CTL) + XB_WORD0; for (int i = threadIdx.x; i < XCD_BAR_WORDS; i += NTHREADS) bw[i] = 0u; }
    for (int rep_ = 0; rep_ < REP_PREP; ++rep_) { p0_prologue(lds); __syncthreads(); }
    grid.sync();
    { KArgs ka = kargs(); (void)xcd_barrier_post((unsigned*)(ka->ws + WS_CTL) + XB_WORD0, (volatile LAS unsigned*)((LAS unsigned char*)lds + XB_LDS_OFF)); }
#pragma unroll 1
    for (int l = 0; l < 2; ++l) {
        const int last = l == 1;
        for (int rep_ = 0; rep_ < REP_NORM; ++rep_) norm_phase(lds, l, 1, l == 0, 0, (SPLITK_CTX && l == 1) ? 16 : 0, (const float*)kargs()->out, (0 * 3 + 2) * 12288 + 5 * 2048, 0);
        grid_bar(lds);
        for (int rep_ = 0; rep_ < REP_INPROJ; ++rep_) {
            KArgs ka = kargs(); unsigned char* wl = FWS + WS_W + (size_t)l * WL_BYTES;
            pg8::Gemm g{(const pg8::bf16_t*)(FWS + WS_H), (const pg8::bf16_t*)(wl + WO_IN), MROWS, INW, DM, DM}; pg8::TileOrder S; S.init(INW, gridDim.x, fresh_bid(), last ? 2 : 0);
            pg8::EpiBf16<0> E{(pg8::bf16_t*)(FWS + WS_P), INW};
            pg8::gemm_phase<pg8::EpiBf16<0>, pg8::TileOrder, true, true>((LAS unsigned char*)lds, g, S, E);
        }
        grid_bar(lds);
        for (int rep_ = 0; rep_ < REP_A2; ++rep_) a2_phase(lds, l, last);
        grid_bar(lds);
        for (int rep_ = 0; rep_ < REP_ATTN; ++rep_) attn_phase(lds, last);
        grid_bar(lds);
        for (int rep_ = 0; rep_ < REP_BAR; ++rep_) grid_bar(lds);
        for (int rep_ = 0; rep_ < REP_OUTPROJ; ++rep_) {
            KArgs ka = kargs(); unsigned char* wl = FWS + WS_W + (size_t)l * WL_BYTES; pg8::bf16_t* X = (pg8::bf16_t*)(FWS + WS_X); const float* mod = (const float*)(FWS + WS_MOD);
            pg8::Gemm g{(const pg8::bf16_t*)(FWS + WS_CAT), (const pg8::bf16_t*)(wl + WO_OUT), MROWS, DM, DM, DM}; pg8::TileOrder S; S.init(DM, gridDim.x, fresh_bid(), (SPLITK_CTX || last) ? 1 : 0);
            pg8::EpiGateRes E{mod + (size_t)l * 3 * 12288 + 2 * 2048, FIN(0), FIN(2), X, ka->out, l == 0 ? 1 : 0, rep_ + 1 < REP_OUTPROJ ? 1 : 0};
            pg8::gemm_phase<pg8::EpiGateRes, pg8::TileOrder, true, true>((LAS unsigned char*)lds, g, S, E);
        }
        if (SPLITK_CTX && !last) {
            KArgs ka = kargs(); unsigned char* wl = FWS + WS_W + (size_t)l * WL_BYTES;
            const int c = fresh_bid(), tile = c >> 3, kc = c & 7;
            pg8::Gemm g{(const pg8::bf16_t*)(FWS + WS_CAT) + kc * 256, (const pg8::bf16_t*)(wl + WO_OUT) + kc * 256, MROWS, DM, 256, DM};
            pg8::OneUnit S{(tile >> 3) * 33, tile & 7, c < 128};
            pg8::EpiSlab E{ka->out + (size_t)(16 + kc) * 512 * 2048};
            pg8::gemm_phase<pg8::EpiSlab, pg8::OneUnit, false, true>((LAS unsigned char*)lds, g, S, E);
        }
        grid_bar(lds);
        for (int rep_ = 0; rep_ < REP_NORM; ++rep_) norm_phase(lds, l, 2, 0, last, (SPLITK_CTX && l == 0) ? 8 : 0, (const float*)kargs()->out + (size_t)16 * 512 * 2048, (0 * 3 + 2) * 12288 + 2 * 2048, 1);
        grid_bar(lds);
        for (int rep_ = 0; rep_ < REP_FF1; ++rep_) {
            KArgs ka = kargs(); unsigned char* wl = FWS + WS_W + (size_t)l * WL_BYTES;
            pg8::Gemm g{(const pg8::bf16_t*)(FWS + WS_H), (const pg8::bf16_t*)(wl + WO_FF1), MROWS, DFF, DM, DM}; pg8::TileOrder S; S.init(DFF, gridDim.x, fresh_bid(), last ? 1 : 0);
            pg8::EpiBf16<2> E{(pg8::bf16_t*)(FWS + WS_U), DFF};
            pg8::gemm_phase<pg8::EpiBf16<2>, pg8::TileOrder, true, true>((LAS unsigned char*)lds, g, S, E);
        }
        grid_bar(lds);
        for (int rep_ = 0; rep_ < REP_FF2; ++rep_) {
            KArgs ka = kargs(); unsigned char* wl = FWS + WS_W + (size_t)l * WL_BYTES; pg8::bf16_t* X = (pg8::bf16_t*)(FWS + WS_X); const float* mod = (const float*)(FWS + WS_MOD);
            pg8::Gemm g{(const pg8::bf16_t*)(FWS + WS_U), (const pg8::bf16_t*)(wl + WO_FF2), MROWS, DM, DFF, DFF}; pg8::TileOrder S; S.init(DM, gridDim.x, fresh_bid(), (SPLITK_CTX || last) ? 1 : 0);
            pg8::EpiGateRes E{mod + (size_t)l * 3 * 12288 + 5 * 2048, FIN(0), FIN(2), X, ka->out, 0, (rep_ + 1 < REP_FF2) ? 1 : last};
            pg8::gemm_phase<pg8::EpiGateRes, pg8::TileOrder, true, true>((LAS unsigned char*)lds, g, S, E);
        }
        if (SPLITK_CTX && !last) {
            KArgs ka = kargs(); unsigned char* wl = FWS + WS_W + (size_t)l * WL_BYTES;
            const int c = fresh_bid(), tile = c >> 4, kc = c & 15;
            pg8::Gemm g{(const pg8::bf16_t*)(FWS + WS_U) + kc * 512, (const pg8::bf16_t*)(wl + WO_FF2) + kc * 512, MROWS, DM, 512, DFF};
            pg8::OneUnit S{(tile >> 3) * 33, tile & 7, c < 256};
            pg8::EpiSlab E{ka->out + (size_t)kc * 512 * 2048};
            pg8::gemm_phase<pg8::EpiSlab, pg8::OneUnit, false, true>((LAS unsigned char*)lds, g, S, E);
        }
        if (!last) grid_bar(lds);
    }
}

extern "C" void kernel_launch(void* const* d_in, const int* in_sizes, int n_in, void* d_out, int out_size, void* d_ws, size_t ws_size, hipStream_t stream) {
    static int grid = 0;
    if (grid == 0) {
        if (n_in != 17 || in_sizes[0] != NB * SEQ * DM || out_size != NB * SEQ * DM || ws_size < WS_END) {
            fprintf(stderr, "kernel_launch: unexpected shapes (n_in %d, in0 %d, out %d, ws %zu; need ws >= %zu)\n", n_in, n_in > 0 ? in_sizes[0] : -1, out_size, ws_size, (size_t)WS_END); grid = -1; return; }
        int dev = 0, cus = 0, per_cu = 0;
        if (hipGetDevice(&dev) != hipSuccess || hipDeviceGetAttribute(&cus, hipDeviceAttributeMultiprocessorCount, dev) != hipSuccess) { grid = -1; return; }
        if (hipFuncSetAttribute((const void*)fwd_megakernel, hipFuncAttributeMaxDynamicSharedMemorySize, LDS_BYTES) != hipSuccess) { fprintf(stderr, "kernel_launch: hipFuncSetAttribute failed\n"); grid = -1; return; }
        if (hipOccupancyMaxActiveBlocksPerMultiprocessor(&per_cu, (const void*)fwd_megakernel, NTHREADS, LDS_BYTES) != hipSuccess || per_cu < 1) { fprintf(stderr, "kernel_launch: occupancy query gave %d\n", per_cu); per_cu = 1; }
        (void)hipGetLastError();
        grid = cus * per_cu;
    }
    if (grid < 0) return;
    Args a{};
    for (int i = 0; i < 17; ++i) a.in[i] = (const float*)d_in[i];
    a.out = (float*)d_out; a.ws = (unsigned char*)d_ws;
    void* params[] = {&a};
    const hipError_t e = hipLaunchCooperativeKernel((const void*)fwd_megakernel, dim3(grid), dim3(NTHREADS), params, LDS_BYTES, stream);
    if (e != hipSuccess) fprintf(stderr, "kernel_launch: cooperative launch failed: %s (grid %d)\n", hipGetErrorString(e), grid);
}
```

```cpp
#include <hip/hip_runtime.h>
#include <hip/hip_bf16.h>
#include <hip/hip_cooperative_groups.h>
#include <cstdio>
#include <cstdint>
namespace cg = cooperative_groups;

constexpr int DM = 2048, NB = 2, SEQ = 8192, CTX = 256, RPB = SEQ + CTX, MROWS = NB * RPB;
constexpr int INW = 3584, DFF = 8192, HD = 128, TPB = RPB / 256;
constexpr int Q_OFF = 0, K_OFF = 1024, V_OFF = 1280, POOL_OFF = 1536, CB_OFF = 2048, CC_OFF = 2560, CV_OFF = 3072;
constexpr float EPS = 1e-6f;
constexpr int NWAVES = 8, NTHREADS = 512;

constexpr size_t MiB = 1u << 20;
constexpr size_t WS_CTL = 0, CTL_BYTES = 1 * MiB;
constexpr size_t WS_MOD = 1 * MiB;
constexpr size_t WS_ROPE = 2 * MiB;
constexpr size_t WS_W = 4 * MiB, WL_BYTES = 86 * MiB;
constexpr size_t WO_IN = 0, WO_OUT = 14 * MiB, WO_FF1 = 22 * MiB, WO_FF2 = 54 * MiB;
constexpr size_t WS_X = WS_W + 2 * WL_BYTES;
constexpr size_t WS_H = WS_X + 132 * MiB;
constexpr size_t WS_U = WS_H + 66 * MiB;
constexpr size_t WS_P = WS_U;
constexpr size_t WS_CAT = WS_U + 116 * MiB;
constexpr size_t WS_KV = WS_CAT + 66 * MiB;
constexpr size_t WS_QN = WS_KV + 17 * MiB;
constexpr size_t WS_END = WS_U + 264 * MiB;
static_assert(WS_KV + (size_t)MROWS * 512 * 2 <= WS_QN && WS_QN + (size_t)MROWS * 1024 * 2 <= WS_END, "overlay");

constexpr int RING_BYTES = 131072, LDS_BYTES = 147456;

typedef unsigned short bf16raw;
typedef unsigned v4u __attribute__((ext_vector_type(4)));
typedef unsigned v2u __attribute__((ext_vector_type(2)));
typedef float v4f __attribute__((ext_vector_type(4)));
#define LAS __attribute__((address_space(3)))

__device__ __forceinline__ unsigned f2bf(float f) { unsigned u = __builtin_bit_cast(unsigned, f); return (u + 0x7fffu + ((u >> 16) & 1u)) >> 16; }
__device__ __forceinline__ unsigned pk2(float lo, float hi) { return f2bf(lo) | (f2bf(hi) << 16); }
__device__ __forceinline__ float bflo(unsigned w) { return __builtin_bit_cast(float, w << 16); }
__device__ __forceinline__ float bfhi(unsigned w) { return __builtin_bit_cast(float, w & 0xffff0000u); }
__device__ __forceinline__ void unpack8(v4u r, float* x) { x[0] = bflo(r.x); x[1] = bfhi(r.x); x[2] = bflo(r.y); x[3] = bfhi(r.y); x[4] = bflo(r.z); x[5] = bfhi(r.z); x[6] = bflo(r.w); x[7] = bfhi(r.w); }
__device__ __forceinline__ v4u pack8(const float* x) { v4u o; o.x = pk2(x[0], x[1]); o.y = pk2(x[2], x[3]); o.z = pk2(x[4], x[5]); o.w = pk2(x[6], x[7]); return o; }
__device__ __forceinline__ float wave_sum(float v) {
#pragma unroll
    for (int o = 1; o < 64; o <<= 1) v += __shfl_xor(v, o);
    return v;
}

__device__ __forceinline__ int fresh_tid() { int t = threadIdx.x; asm volatile("" : "+v"(t)); return t; }
__device__ __forceinline__ int fresh_bid() { int b = blockIdx.x; asm volatile("" : "+s"(b)); return b; }

namespace pg8 {
#define PG8_LAS __attribute__((address_space(3)))
typedef unsigned short bf16_t;
typedef short bf16x8 __attribute__((ext_vector_type(8)));
typedef float f32x4 __attribute__((ext_vector_type(4)));
typedef unsigned u32x4 __attribute__((ext_vector_type(4)));
constexpr int BM = 256, BK = 64, HALF = 128, HTB = HALF * BK * 2  , STAGE_BYTES = 8 * HTB, NXCD = 8, WGM = 8;

__host__ __device__ __forceinline__ int lds_byte(int r, int c) { const int st = (r >> 4) * 2 + (c >> 5), rr = r & 15, cc = c & 31, ob = rr * 64 + cc * 2; return st * 1024 + (ob ^ (((ob >> 9) & 1) << 5)); }
__host__ __device__ __forceinline__ void stage_rc(int b, int& R, int& C) { const int st = b / 1024, sb = b % 1024, swz = sb ^ (((sb >> 9) & 1) << 5); R = (st >> 1) * 16 + swz / 64; C = (st & 1) * 32 + (swz % 64) / 2; }
__host__ __device__ __forceinline__ int perm32(int rho) { const int n = rho >> 4, i = rho & 15; return 8 * (i >> 2) + 4 * n + (i & 3); }

struct Unit { int pm, pn; };
struct Gemm { const bf16_t* A; const bf16_t* Bt; int M, N, K, ld; };

struct TileOrder {
    int nM, nN, nMain, nwg, G, c, mode;
    __device__ void init(int N, int G_, int c_, int mode_) { mode = mode_; nM = mode_ == 0 ? 66 : 64; nN = N / BM; nMain = nM * nN; nwg = nMain + (mode_ == 2 ? 4 : 0); G = G_; c = c_; }
    __device__ bool next(int i, Unit& u) const {
        const long L = (long)i * G + c; if (L >= nwg) return false;
        int wgid = (int)L; { const int q = nwg / NXCD, r = nwg % NXCD, xcd = wgid % NXCD, off = wgid / NXCD; wgid = (xcd < r ? xcd * (q + 1) : r * (q + 1) + (xcd - r) * q) + off; }
        if (wgid >= nMain) { const int e = wgid - nMain; u.pm = (e >> 1) * 33; u.pn = 4 + (e & 1); return true; }
        const int nig = WGM * nN, gid = wgid / nig, fm = gid * WGM, gsz = (nM - fm) < WGM ? (nM - fm) : WGM;
        const int mt = fm + ((wgid % nig) % gsz); u.pn = (wgid % nig) / gsz;
        u.pm = mode == 0 ? mt : (mt >> 5) * 33 + 1 + (mt & 31); return true;
    }
    __device__ __forceinline__ void a_ready(const Unit&) const {}
    __device__ __forceinline__ void done(const Unit&) const {}
};
struct OneUnit {
    int pm, pn, has;
    __device__ __forceinline__ bool next(int i, Unit& u) const { if (i != 0 || !has) return false; u.pm = pm; u.pn = pn; return true; }
    __device__ __forceinline__ void a_ready(const Unit&) const {}
    __device__ __forceinline__ void done(const Unit&) const {}
};
__device__ __forceinline__ unsigned cvt_pk_bf16(float lo, float hi) { unsigned r; asm volatile("v_cvt_pk_bf16_f32 %0, %1, %2" : "=v"(r) : "v"(lo), "v"(hi)); return r; }
typedef float f32x2 __attribute__((ext_vector_type(2)));
template <int ACT  > struct EpiBf16 {
    static constexpr bool PERM = true, AFTER_DRAIN = false;
    bf16_t* O; int ldc;
    __device__ __forceinline__ void operator()(const f32x4 (&acc)[2][2][4][2], const Unit& u, int wr, int wc, int fr, int fq) const {
        const int row0 = u.pm * BM + wr * 64 + fr; const int col0 = u.pn * BM + wc * 32 + 8 * fq;
#pragma unroll
        for (int ai = 0; ai < 2; ++ai)
#pragma unroll
            for (int m = 0; m < 4; ++m) { bf16_t* rowp = O + (size_t)(row0 + ai * HALF + m * 16) * ldc + col0;
#pragma unroll
                for (int bj = 0; bj < 2; ++bj) { f32x4 v0 = acc[ai][bj][m][0], v1 = acc[ai][bj][m][1];
                    if (ACT == 2) { const f32x4 z = {0.f, 0.f, 0.f, 0.f}; v0 = __builtin_elementwise_max(v0, z); v1 = __builtin_elementwise_max(v1, z); v0 = v0 * v0; v1 = v1 * v1; }
                    u32x4 w; w.x = cvt_pk_bf16(v0[0], v0[1]); w.y = cvt_pk_bf16(v0[2], v0[3]); w.z = cvt_pk_bf16(v1[0], v1[1]); w.w = cvt_pk_bf16(v1[2], v1[3]);
                    *(u32x4*)(rowp + bj * HALF) = w; } }
    }
};
struct EpiGateRes {
    static constexpr bool PERM = true, AFTER_DRAIN = false;
    const float* gate;
    const float* xin; const float* ctxin;
    bf16_t* X; float* out;
    int in_mode, out_mode;
    __device__ __forceinline__ void operator()(const f32x4 (&acc)[2][2][4][2], const Unit& u, int wr, int wc, int fr, int fq) const {
        const int b = u.pm / 33, jt = u.pm % 33, s = jt == 0 ? 2 : b;
        const size_t lat_off = ((size_t)b * 8192 + (size_t)(jt - 1) * 256) * 2048;
        const float* basef = jt == 0 ? ctxin + (size_t)b * 256 * 2048 : xin + lat_off;
        bf16_t* xb = X + (size_t)u.pm * 256 * 2048; float* outf = out + lat_off;
        const int col0 = u.pn * BM + wc * 32 + 8 * fq; const float* gp = gate + (size_t)s * 12288 + col0;
        f32x4 gv[2][2];
#pragma unroll
        for (int bj = 0; bj < 2; ++bj)
#pragma unroll
            for (int n = 0; n < 2; ++n) gv[bj][n] = *(const f32x4*)(gp + bj * HALF + n * 4);
#pragma unroll
        for (int ai = 0; ai < 2; ++ai)
#pragma unroll
            for (int m = 0; m < 4; ++m) { const size_t off = (size_t)(ai * HALF + wr * 64 + m * 16 + fr) * 2048 + col0;
#pragma unroll
                for (int bj = 0; bj < 2; ++bj) { f32x4 b0, b1;
                    if (in_mode) { b0 = *(const f32x4*)(basef + off + bj * HALF); b1 = *(const f32x4*)(basef + off + bj * HALF + 4); }
                    else { const u32x4 w = *(const u32x4*)(xb + off + bj * HALF);
                        b0 = (f32x4){__builtin_bit_cast(float, w.x << 16), __builtin_bit_cast(float, w.x & 0xffff0000u), __builtin_bit_cast(float, w.y << 16), __builtin_bit_cast(float, w.y & 0xffff0000u)};
                        b1 = (f32x4){__builtin_bit_cast(float, w.z << 16), __builtin_bit_cast(float, w.z & 0xffff0000u), __builtin_bit_cast(float, w.w << 16), __builtin_bit_cast(float, w.w & 0xffff0000u)}; }
                    const f32x4 o0 = b0 + gv[bj][0] * acc[ai][bj][m][0], o1 = b1 + gv[bj][1] * acc[ai][bj][m][1];
                    if (out_mode) { *(f32x4*)(outf + off + bj * HALF) = o0; *(f32x4*)(outf + off + bj * HALF + 4) = o1; }
                    else { u32x4 w; w.x = cvt_pk_bf16(o0[0], o0[1]); w.y = cvt_pk_bf16(o0[2], o0[3]); w.z = cvt_pk_bf16(o1[0], o1[1]); w.w = cvt_pk_bf16(o1[2], o1[3]); *(u32x4*)(xb + off + bj * HALF) = w; } }
                if (m & 1) asm volatile("" ::: "memory"); }
    }
};

struct EpiGateAtomic {
    static constexpr bool PERM = false, AFTER_DRAIN = false;
    const float* gate; float* X;
    __device__ __forceinline__ void operator()(const f32x4 (&acc)[2][2][4][2], const Unit& u, int wr, int wc, int fr, int fq) const {
        const int b = u.pm / 33, jt = u.pm % 33, s = jt == 0 ? 2 : b;
        float* outp = X + (size_t)u.pm * 256 * 2048;
        const int col0 = u.pn * BM + wc * 32 + 4 * fq; const float* gp = gate + (size_t)s * 12288 + col0;
        f32x4 gv[2][2];
#pragma unroll
        for (int bj = 0; bj < 2; ++bj)
#pragma unroll
            for (int n = 0; n < 2; ++n) gv[bj][n] = *(const f32x4*)(gp + bj * HALF + n * 16);
#pragma unroll
        for (int ai = 0; ai < 2; ++ai)
#pragma unroll
            for (int m = 0; m < 4; ++m) { const size_t off = (size_t)(ai * HALF + wr * 64 + m * 16 + fr) * 2048 + col0;
#pragma unroll
                for (int bj = 0; bj < 2; ++bj)
#pragma unroll
                    for (int n = 0; n < 2; ++n) { const f32x4 v = gv[bj][n] * acc[ai][bj][m][n]; float* p = outp + off + bj * HALF + n * 16;
#pragma unroll
                        for (int e = 0; e < 4; ++e) (void)__hip_atomic_fetch_add(p + e, v[e], __ATOMIC_RELAXED, __HIP_MEMORY_SCOPE_AGENT); } }
    }
};

struct EpiSlab {
    static constexpr bool PERM = false, AFTER_DRAIN = false;
    float* slab;
    __device__ __forceinline__ void operator()(const f32x4 (&acc)[2][2][4][2], const Unit& u, int wr, int wc, int fr, int fq) const {
        float* outp = slab + (size_t)(u.pm / 33) * 256 * 2048;
        const int col0 = u.pn * BM + wc * 32 + 4 * fq;
#pragma unroll
        for (int ai = 0; ai < 2; ++ai)
#pragma unroll
            for (int m = 0; m < 4; ++m) { const size_t off = (size_t)(ai * HALF + wr * 64 + m * 16 + fr) * 2048 + col0;
#pragma unroll
                for (int bj = 0; bj < 2; ++bj)
#pragma unroll
                    for (int n = 0; n < 2; ++n) *(f32x4*)(outp + off + bj * HALF + n * 16) = acc[ai][bj][m][n]; }
    }
};

template <class Epi, class Sched, bool ALIGN_EPI = false, bool SP2 = false>
__device__ __forceinline__ void gemm_phase(PG8_LAS unsigned char* lds, const Gemm g, const Sched& S, const Epi& E) {
    const int tid = fresh_tid(), wid = __builtin_amdgcn_readfirstlane(tid >> 6), lane = tid & 63, wr = wid >> 2, wc = wid & 3, fr = lane & 15, fq = lane >> 4;
    const int K = g.ld, nt = g.K / BK;
    unsigned voffA[2], voffB[2];
#pragma unroll
    for (int i = 0; i < 2; ++i) { int R, C; stage_rc(tid * 16 + i * 8192, R, C); const int Rb = Epi::PERM ? ((R & ~31) + perm32(R & 31)) : R;
        voffA[i] = (unsigned)(R * K + C) * 2u; voffB[i] = (unsigned)(Rb * K + C) * 2u; }
    const size_t kstep = (size_t)(BK * 2);
    const size_t hstep = (size_t)HALF * K * 2;
    const size_t tstep = 2 * hstep;
    const unsigned ldsw = (unsigned)wid * 1024u;
    const int aoff = lds_byte(wr * 64 + fr, fq * 8), boff = lds_byte(wc * 32 + fr, fq * 8);
#define PG8_SA(b, h) (((b) * 2 + (h)) * HTB)
#define PG8_SB(b, h) ((4 + (b) * 2 + (h)) * HTB)
#define PG8_STAGE(bufoff, gbase, voff) do { _Pragma("unroll") for (int _i = 0; _i < 2; ++_i) \
        __builtin_amdgcn_global_load_lds((const unsigned*)((const char*)(gbase) + (voff)[_i]), (PG8_LAS unsigned*)(lds + (bufoff) + ldsw + _i * 8192), 16, 0, 0); } while (0)
#define PG8_LDA(dst, b, h) do { _Pragma("unroll") for (int m = 0; m < 4; ++m) _Pragma("unroll") for (int k = 0; k < 2; ++k) dst[m][k] = *(const PG8_LAS bf16x8*)(lds + PG8_SA(b, h) + aoff + m * 2048 + k * 1024); } while (0)
#define PG8_LDB(dst, b, h) do { _Pragma("unroll") for (int n = 0; n < 2; ++n) _Pragma("unroll") for (int k = 0; k < 2; ++k) dst[n][k] = *(const PG8_LAS bf16x8*)(lds + PG8_SB(b, h) + boff + n * 2048 + k * 1024); } while (0)
#define PG8_MMA(ai, bj, At, Bt) do { __builtin_amdgcn_s_setprio(1); _Pragma("unroll") for (int m = 0; m < 4; ++m) _Pragma("unroll") for (int n = 0; n < 2; ++n) _Pragma("unroll") for (int k = 0; k < 2; ++k) \
        acc[ai][bj][m][n] = __builtin_amdgcn_mfma_f32_16x16x32_bf16(Bt[n][k], At[m][k], acc[ai][bj][m][n], 0, 0, 0); __builtin_amdgcn_s_setprio(0); } while (0)
#define PG8_WAIT_V(n) asm volatile("s_waitcnt vmcnt(" #n ")" ::: "memory")
#define PG8_WAIT_L(n) asm volatile("s_waitcnt lgkmcnt(" #n ")" ::: "memory")
#define PG8_BAR __builtin_amdgcn_s_barrier()
#define PG8_SCHED __builtin_amdgcn_sched_barrier(0)
    Unit cur, nxt; int ui = 0;
    if (!S.next(0, cur)) return;
    f32x4 acc[2][2][4][2];
#pragma unroll
    for (int a = 0; a < 2; ++a)
#pragma unroll
        for (int b = 0; b < 2; ++b)
#pragma unroll
            for (int m = 0; m < 4; ++m)
#pragma unroll
                for (int n = 0; n < 2; ++n) acc[a][b][m][n] = (f32x4){0.f, 0.f, 0.f, 0.f};
    bf16x8 At[4][2], B0[2][2], B1[2][2];
    const char* cA = (const char*)g.A + (size_t)cur.pm * tstep; const char* cB = (const char*)g.Bt + (size_t)cur.pn * tstep;
    S.a_ready(cur);
    if constexpr (SP2) {
        PG8_STAGE(PG8_SB(0, 0), cB, voffB); PG8_STAGE(PG8_SB(0, 1), cB + hstep, voffB); PG8_STAGE(PG8_SA(0, 0), cA, voffA); PG8_STAGE(PG8_SA(0, 1), cA + hstep, voffA);
        if (wr == 1) PG8_BAR;
        PG8_WAIT_V(2); PG8_BAR;
        PG8_STAGE(PG8_SB(1, 0), cB + kstep, voffB); PG8_STAGE(PG8_SA(1, 0), cA + kstep, voffA); PG8_STAGE(PG8_SB(1, 1), cB + hstep + kstep, voffB);
        PG8_WAIT_V(6); PG8_BAR;
    } else {
        PG8_STAGE(PG8_SB(0, 0), cB, voffB); PG8_STAGE(PG8_SA(0, 0), cA, voffA); PG8_STAGE(PG8_SB(0, 1), cB + hstep, voffB); PG8_STAGE(PG8_SA(0, 1), cA + hstep, voffA);
        if (wr == 1) PG8_BAR;
        PG8_WAIT_V(4); PG8_BAR;
        PG8_STAGE(PG8_SB(1, 0), cB + kstep, voffB); PG8_STAGE(PG8_SA(1, 0), cA + kstep, voffA); PG8_STAGE(PG8_SB(1, 1), cB + hstep + kstep, voffB);
        PG8_WAIT_V(6); PG8_BAR;
    }
    for (;;) {
        const bool has_next = S.next(ui + 1, nxt);
        const char* nA = has_next ? (const char*)g.A + (size_t)nxt.pm * tstep : cA; const char* nB = has_next ? (const char*)g.Bt + (size_t)nxt.pn * tstep : cB;
        for (int t = 0; t < nt; t += 2) {
            const bool last = (t == nt - 2);
            const char* a1 = cA + (size_t)(t + 1) * kstep;
            const char* a2 = last ? nA : cA + (size_t)(t + 2) * kstep; const char* b2 = last ? nB : cB + (size_t)(t + 2) * kstep;
            const char* a3 = a2 + kstep; const char* b3 = b2 + kstep;
            if (last && has_next) S.a_ready(nxt);
            if constexpr (SP2) {
            PG8_LDB(B0, 0, 0); PG8_LDB(B1, 0, 1); PG8_SCHED; PG8_LDA(At, 0, 0); PG8_STAGE(PG8_SA(1, 1), a1 + hstep, voffA);
            PG8_WAIT_V(8); PG8_WAIT_L(0); PG8_BAR; PG8_MMA(0, 0, At, B0); PG8_MMA(0, 1, At, B1); PG8_BAR; PG8_SCHED;
            PG8_LDA(At, 0, 1); PG8_STAGE(PG8_SB(0, 0), b2, voffB); PG8_STAGE(PG8_SB(0, 1), b2 + hstep, voffB); PG8_STAGE(PG8_SA(0, 0), a2, voffA);
            PG8_WAIT_V(8); PG8_WAIT_L(0); PG8_BAR; PG8_MMA(1, 0, At, B0); PG8_MMA(1, 1, At, B1); PG8_BAR; PG8_SCHED;
            PG8_LDB(B0, 1, 0); PG8_LDB(B1, 1, 1); PG8_SCHED; PG8_LDA(At, 1, 0); PG8_STAGE(PG8_SA(0, 1), a2 + hstep, voffA);
            PG8_WAIT_V(8); PG8_WAIT_L(0); PG8_BAR; PG8_MMA(0, 0, At, B0); PG8_MMA(0, 1, At, B1); PG8_BAR; PG8_SCHED;
            PG8_LDA(At, 1, 1); PG8_STAGE(PG8_SB(1, 0), b3, voffB); PG8_STAGE(PG8_SB(1, 1), b3 + hstep, voffB); PG8_STAGE(PG8_SA(1, 0), a3, voffA);
            PG8_WAIT_V(8); PG8_WAIT_L(0); PG8_BAR; PG8_MMA(1, 0, At, B0); PG8_MMA(1, 1, At, B1); PG8_BAR; PG8_SCHED;
            } else {
            PG8_LDB(B0, 0, 0); PG8_SCHED; PG8_LDA(At, 0, 0); PG8_STAGE(PG8_SA(1, 1), a1 + hstep, voffA);
            PG8_WAIT_L(8); PG8_BAR; PG8_WAIT_L(0); PG8_MMA(0, 0, At, B0); PG8_BAR; PG8_SCHED;
            PG8_LDB(B1, 0, 1); PG8_STAGE(PG8_SB(0, 0), b2, voffB);
            PG8_BAR; PG8_WAIT_L(0); PG8_MMA(0, 1, At, B1); PG8_BAR;
            PG8_LDA(At, 0, 1); PG8_STAGE(PG8_SA(0, 0), a2, voffA);
            PG8_BAR; PG8_WAIT_L(0); PG8_MMA(1, 0, At, B0); PG8_BAR; PG8_SCHED;
            PG8_STAGE(PG8_SB(0, 1), b2 + hstep, voffB);
            PG8_WAIT_V(6); PG8_BAR; PG8_MMA(1, 1, At, B1); PG8_BAR;
            PG8_LDB(B0, 1, 0); PG8_SCHED; PG8_LDA(At, 1, 0); PG8_STAGE(PG8_SA(0, 1), a2 + hstep, voffA);
            PG8_WAIT_L(8); PG8_BAR; PG8_WAIT_L(0); PG8_MMA(0, 0, At, B0); PG8_BAR; PG8_SCHED;
            PG8_LDB(B1, 1, 1); PG8_STAGE(PG8_SB(1, 0), b3, voffB);
            PG8_BAR; PG8_WAIT_L(0); PG8_MMA(0, 1, At, B1); PG8_BAR;
            PG8_LDA(At, 1, 1); PG8_STAGE(PG8_SA(1, 0), a3, voffA);
            PG8_BAR; PG8_WAIT_L(0); PG8_MMA(1, 0, At, B0); PG8_BAR; PG8_SCHED;
            PG8_STAGE(PG8_SB(1, 1), b3 + hstep, voffB);
            PG8_WAIT_V(6); PG8_BAR; PG8_MMA(1, 1, At, B1); PG8_BAR;
            }
        }
        if constexpr (ALIGN_EPI) { if (wr == 0) PG8_BAR; }
        if constexpr (!Epi::AFTER_DRAIN) { E(acc, cur, wr, wc, fr, fq); S.done(cur); }
        if (!has_next) break;
#pragma unroll
        for (int a = 0; a < 2; ++a)
#pragma unroll
            for (int b = 0; b < 2; ++b)
#pragma unroll
                for (int m = 0; m < 4; ++m)
#pragma unroll
                    for (int n = 0; n < 2; ++n) acc[a][b][m][n] = (f32x4){0.f, 0.f, 0.f, 0.f};
        cur = nxt; cA = nA; cB = nB; ++ui;
        if constexpr (ALIGN_EPI) { if (wr == 1) PG8_BAR; }
    }
    PG8_WAIT_V(0);
    if constexpr (!ALIGN_EPI) { if (wr == 0) PG8_BAR; }
    PG8_BAR;
    if constexpr (Epi::AFTER_DRAIN) { E.fused(acc, cur, wr, wc, fr, fq, lds, wid, lane); S.done(cur); }
#undef PG8_SA
#undef PG8_SB
#undef PG8_STAGE
#undef PG8_LDA
#undef PG8_LDB
#undef PG8_MMA
#undef PG8_WAIT_V
#undef PG8_WAIT_L
#undef PG8_BAR
#undef PG8_SCHED
}
}
namespace att {
using bf16 = __hip_bfloat16;
constexpr int   D = 128, NW = 8, QBLK = 32, KVBLK = 64;
constexpr float SCALE = 0.088388347648318440f;
constexpr float THR = 8.f;
constexpr int SDEPTH = 1;
constexpr size_t SHM_V = KVBLK * D * 2, SHM_K = KVBLK * D * 2, SHM_ATTN = 3 * SHM_V + 3 * SHM_K + NW * 64 * 4;
using bf16x8 = __attribute__((ext_vector_type(8))) short;
using s16x4  = __attribute__((ext_vector_type(4))) short;
using f32x16 = __attribute__((ext_vector_type(16))) float;
using f32x8  = __attribute__((ext_vector_type(8))) float;
using u32x4  = __attribute__((ext_vector_type(4))) unsigned;
#define KSWZ(row, colB) ((row) * 256 + ((colB) ^ (((row) & 7) << 4)))
#define SBAR() __builtin_amdgcn_sched_barrier(0)
__device__ __forceinline__ int crow(int r, int hi) { return (r & 3) + 8 * (r >> 2) + 4 * hi; }
__device__ __forceinline__ unsigned cvtpk(float lo, float hi) {
  unsigned r; asm volatile("v_cvt_pk_bf16_f32 %0, %1, %2" : "=v"(r) : "v"(lo), "v"(hi)); return r;
}
template <typename TIn> struct Stage;
template <> struct Stage<bf16>  { using T = bf16x8;
  __device__ static __forceinline__ T ld8(const bf16* p) { return *reinterpret_cast<const bf16x8*>(p); }
  __device__ static __forceinline__ bf16x8 tobf(T x) { return x; } };
template <> struct Stage<float> { using T = f32x8;
  __device__ static __forceinline__ T ld8(const float* p) { return *reinterpret_cast<const f32x8*>(p); }
  __device__ static __forceinline__ bf16x8 tobf(T x) {
    u32x4 w = {cvtpk(x[0], x[1]), cvtpk(x[2], x[3]), cvtpk(x[4], x[5]), cvtpk(x[6], x[7])}; return *reinterpret_cast<bf16x8*>(&w); } };

__device__ __forceinline__ void partialSM(f32x16& p0, f32x16& p1, float& m_reg, f32x16& negm, float& alpha) {
  constexpr float THRL = THR * 1.4426950408889634f;
  float pmax = p0[0]; for (int r = 1; r < 16; ++r) pmax = fmaxf(pmax, p0[r]); for (int r = 0; r < 16; ++r) pmax = fmaxf(pmax, p1[r]);
  { auto rr = __builtin_amdgcn_permlane32_swap(__float_as_uint(pmax), __float_as_uint(pmax), false, false);
    pmax = fmaxf(__uint_as_float(rr[0]), __uint_as_float(rr[1])); }
  if (__builtin_expect(__all(pmax <= THRL), 1)) { alpha = 1.f; }
  else { const float dl = fmaxf(pmax, 0.f); m_reg += dl; alpha = __builtin_amdgcn_exp2f(-dl);
    for (int r = 0; r < 16; ++r) { p0[r] -= dl; p1[r] -= dl; }
    const float nm = -m_reg; for (int r = 0; r < 16; ++r) negm[r] = nm; }
  for (int r = 0; r < 16; ++r) p0[r] = __builtin_amdgcn_exp2f(p0[r]);
}
__device__ __forceinline__ void finishSM(f32x16& p0, f32x16& p1, float alpha, float& l_reg, bf16x8& pa0, bf16x8& pa1, bf16x8& pa2, bf16x8& pa3) {
  for (int r = 0; r < 16; ++r) p1[r] = __builtin_amdgcn_exp2f(p1[r]);
  float ps = 0; for (int r = 0; r < 16; ++r) ps += p0[r]; for (int r = 0; r < 16; ++r) ps += p1[r];
  { auto rr = __builtin_amdgcn_permlane32_swap(__float_as_uint(ps), __float_as_uint(ps), false, false);
    ps = __uint_as_float(rr[0]) + __uint_as_float(rr[1]); }
  l_reg = l_reg * alpha + ps;
#define PK4(P, BASE, OUT) do { unsigned a0 = cvtpk(P[BASE + 0], P[BASE + 1]), a1 = cvtpk(P[BASE + 2], P[BASE + 3]);   \
    unsigned b0 = cvtpk(P[BASE + 4], P[BASE + 5]), b1 = cvtpk(P[BASE + 6], P[BASE + 7]);                              \
    auto r0 = __builtin_amdgcn_permlane32_swap(a0, b0, false, false); auto r1 = __builtin_amdgcn_permlane32_swap(a1, b1, false, false); \
    u32x4 w = {r0[0], r1[0], r0[1], r1[1]}; OUT = *reinterpret_cast<bf16x8*>(&w); } while (0)
  PK4(p0, 0, pa0); PK4(p0, 8, pa1); PK4(p1, 0, pa2); PK4(p1, 8, pa3);
#undef PK4
}
__device__ __forceinline__ void qkt(f32x16& p0, f32x16& p1, const bf16* Ks, const bf16x8* qr, const f32x16& negm, int r32, int hi) {
#pragma unroll
  for (int d0 = 0; d0 < 8; ++d0) { int cb = (d0 * 16 + hi * 8) * 2;
    bf16x8 b0 = *reinterpret_cast<const bf16x8*>((const char*)Ks + KSWZ(r32, cb));
    bf16x8 b1 = *reinterpret_cast<const bf16x8*>((const char*)Ks + KSWZ(32 + r32, cb));
    if (d0 == 0) { p0 = __builtin_amdgcn_mfma_f32_32x32x16_bf16(b0, qr[0], negm, 0, 0, 0); p1 = __builtin_amdgcn_mfma_f32_32x32x16_bf16(b1, qr[0], negm, 0, 0, 0); }
    else { p0 = __builtin_amdgcn_mfma_f32_32x32x16_bf16(b0, qr[d0], p0, 0, 0, 0); p1 = __builtin_amdgcn_mfma_f32_32x32x16_bf16(b1, qr[d0], p1, 0, 0, 0); } }
}
__device__ __forceinline__ void qkt_fin(f32x16& n0, f32x16& n1, const bf16* Ks, const bf16x8* qr, const f32x16& negm, int r32, int hi,
                                        f32x16& p0, f32x16& p1, float alpha, float& l_reg, bf16x8& pa0, bf16x8& pa1, bf16x8& pa2, bf16x8& pa3) {
#define KFR(d0, B0, B1) do { const int cb_ = ((d0) * 16 + hi * 8) * 2; B0 = *reinterpret_cast<const bf16x8*>((const char*)Ks + KSWZ(r32, cb_)); B1 = *reinterpret_cast<const bf16x8*>((const char*)Ks + KSWZ(32 + r32, cb_)); } while (0)
#define QKM(d0, B0, B1) do { if ((d0) == 0) { n0 = __builtin_amdgcn_mfma_f32_32x32x16_bf16(B0, qr[0], negm, 0, 0, 0); n1 = __builtin_amdgcn_mfma_f32_32x32x16_bf16(B1, qr[0], negm, 0, 0, 0); } \
    else { n0 = __builtin_amdgcn_mfma_f32_32x32x16_bf16(B0, qr[d0], n0, 0, 0, 0); n1 = __builtin_amdgcn_mfma_f32_32x32x16_bf16(B1, qr[d0], n1, 0, 0, 0); } } while (0)
#define EX4(P, B) do { P[B] = __builtin_amdgcn_exp2f(P[B]); P[B + 1] = __builtin_amdgcn_exp2f(P[B + 1]); P[B + 2] = __builtin_amdgcn_exp2f(P[B + 2]); P[B + 3] = __builtin_amdgcn_exp2f(P[B + 3]); } while (0)
#define SUM8(P, B) (((P[B] + P[B + 1]) + (P[B + 2] + P[B + 3])) + ((P[B + 4] + P[B + 5]) + (P[B + 6] + P[B + 7])))
#define PKQ(P, BASE, OUT) do { unsigned a0 = cvtpk(P[BASE + 0], P[BASE + 1]), a1 = cvtpk(P[BASE + 2], P[BASE + 3]);   \
    unsigned b0_ = cvtpk(P[BASE + 4], P[BASE + 5]), b1_ = cvtpk(P[BASE + 6], P[BASE + 7]);                              \
    auto r0 = __builtin_amdgcn_permlane32_swap(a0, b0_, false, false); auto r1 = __builtin_amdgcn_permlane32_swap(a1, b1_, false, false); \
    u32x4 w = {r0[0], r1[0], r0[1], r1[1]}; OUT = *reinterpret_cast<bf16x8*>(&w); } while (0)
  bf16x8 ka0, ka1; float s0, s1;
  KFR(0, ka0, ka1); SBAR();
  QKM(0, ka0, ka1); KFR(1, ka0, ka1); EX4(p1, 0); s0 = SUM8(p0, 0); SBAR();
  QKM(1, ka0, ka1); KFR(2, ka0, ka1); EX4(p1, 4); PKQ(p0, 0, pa0); SBAR();
  QKM(2, ka0, ka1); KFR(3, ka0, ka1); EX4(p1, 8); s0 += SUM8(p0, 8); SBAR();
  QKM(3, ka0, ka1); KFR(4, ka0, ka1); EX4(p1, 12); PKQ(p0, 8, pa1); SBAR();
  QKM(4, ka0, ka1); KFR(5, ka0, ka1); s1 = SUM8(p1, 0); SBAR();
  QKM(5, ka0, ka1); KFR(6, ka0, ka1); PKQ(p1, 0, pa2); SBAR();
  QKM(6, ka0, ka1); KFR(7, ka0, ka1); s1 += SUM8(p1, 8); SBAR();
  QKM(7, ka0, ka1); PKQ(p1, 8, pa3);
  { float ps = s0 + s1; auto rr = __builtin_amdgcn_permlane32_swap(__float_as_uint(ps), __float_as_uint(ps), false, false);
    ps = __uint_as_float(rr[0]) + __uint_as_float(rr[1]); l_reg = l_reg * alpha + ps; }
  SBAR();
#undef KFR
#undef QKM
#undef SUM8
#undef PKQ
}
__device__ __forceinline__ int v_st(int k, int c) { const int kk = (k & ~0xC) | ((k & 4) << 1) | ((k & 8) >> 1); return ((kk >> 3) * 4 + (c >> 5)) * 512 + ((kk & 7) * 32 + (c & 31)) * 2; }
__device__ __forceinline__ int v_rd_base(int lane) { return ((lane & 3) << 3) | (((lane >> 2) & 3) << 6) | (((lane >> 4) & 1) << 5) | (((lane >> 5) & 1) << 8); }
constexpr int v_rd_off(int d0, int ks, int half) { return d0 * 512 + ks * 4096 + half * 2048; }
template <int OFF> __device__ __forceinline__ s16x4 tr_read(int vb) {
  s16x4 r; asm volatile("ds_read_b64_tr_b16 %0, %1 offset:%2" : "=&v"(r) : "v"(vb), "i"(OFF) : "memory"); return r;
}
template <int D0> __device__ __forceinline__ void pv_one(f32x16& od, int vb, bf16x8 pa0, bf16x8 pa1, bf16x8 pa2, bf16x8 pa3) {
  const s16x4 l0 = tr_read<v_rd_off(D0, 0, 0)>(vb), h0 = tr_read<v_rd_off(D0, 0, 1)>(vb), l1 = tr_read<v_rd_off(D0, 1, 0)>(vb), h1 = tr_read<v_rd_off(D0, 1, 1)>(vb);
  const s16x4 l2 = tr_read<v_rd_off(D0, 2, 0)>(vb), h2 = tr_read<v_rd_off(D0, 2, 1)>(vb), l3 = tr_read<v_rd_off(D0, 3, 0)>(vb), h3 = tr_read<v_rd_off(D0, 3, 1)>(vb);
  asm volatile("s_waitcnt lgkmcnt(0)" ::: "memory"); SBAR();
#define PK(L, H) (bf16x8){L[0], L[1], L[2], L[3], H[0], H[1], H[2], H[3]}
  od = __builtin_amdgcn_mfma_f32_32x32x16_bf16(pa0, PK(l0, h0), od, 0, 0, 0);
  od = __builtin_amdgcn_mfma_f32_32x32x16_bf16(pa1, PK(l1, h1), od, 0, 0, 0);
  od = __builtin_amdgcn_mfma_f32_32x32x16_bf16(pa2, PK(l2, h2), od, 0, 0, 0);
  od = __builtin_amdgcn_mfma_f32_32x32x16_bf16(pa3, PK(l3, h3), od, 0, 0, 0);
#undef PK
}
__device__ __forceinline__ void pv_part(f32x16* o, int vb, bf16x8 pa0, bf16x8 pa1, bf16x8 pa2, bf16x8 pa3, f32x16& p0, f32x16& p1, float& m_reg, f32x16& negm, float& alpha) {
  constexpr float THRL = THR * 1.4426950408889634f;
  pv_one<0>(o[0], vb, pa0, pa1, pa2, pa3);
  float ma = fmaxf(fmaxf(p0[0], p0[1]), p0[2]); for (int r = 3; r < 15; r += 2) ma = fmaxf(fmaxf(ma, p0[r]), p0[r + 1]); ma = fmaxf(ma, p0[15]);
  pv_one<1>(o[1], vb, pa0, pa1, pa2, pa3);
  float mb = fmaxf(fmaxf(p1[0], p1[1]), p1[2]); for (int r = 3; r < 15; r += 2) mb = fmaxf(fmaxf(mb, p1[r]), p1[r + 1]); mb = fmaxf(mb, p1[15]);
  float pmax = fmaxf(ma, mb);
  { auto rr = __builtin_amdgcn_permlane32_swap(__float_as_uint(pmax), __float_as_uint(pmax), false, false);
    pmax = fmaxf(__uint_as_float(rr[0]), __uint_as_float(rr[1])); }
  if (__builtin_expect(__all(pmax <= THRL), 1)) { alpha = 1.f; }
  else { const float dl = fmaxf(pmax, 0.f); m_reg += dl; alpha = __builtin_amdgcn_exp2f(-dl);
    for (int r = 0; r < 16; ++r) { p0[r] -= dl; p1[r] -= dl; }
    const float nm = -m_reg; for (int r = 0; r < 16; ++r) negm[r] = nm; }
  pv_one<2>(o[2], vb, pa0, pa1, pa2, pa3); EX4(p0, 0); EX4(p0, 4);
  pv_one<3>(o[3], vb, pa0, pa1, pa2, pa3); EX4(p0, 8); EX4(p0, 12);
#undef EX4
}
__device__ __forceinline__ void pv_d0(f32x16* o, int vb, bf16x8 pa0, bf16x8 pa1, bf16x8 pa2, bf16x8 pa3) {
  pv_one<0>(o[0], vb, pa0, pa1, pa2, pa3); pv_one<1>(o[1], vb, pa0, pa1, pa2, pa3); pv_one<2>(o[2], vb, pa0, pa1, pa2, pa3); pv_one<3>(o[3], vb, pa0, pa1, pa2, pa3);
}
template <int LDQ, int LDK, int LDO>
__device__ __forceinline__ void attn_dense_body(const bf16* __restrict__ Qb, const bf16* __restrict__ Kh, const bf16* __restrict__ Vh,
                                                bf16* __restrict__ Ob, int seq, char* lds) {
  using TQ = bf16;
  using St = Stage<bf16>; using SQ = Stage<TQ>;
  const int tid = fresh_tid(), wid = tid >> 6, lane = tid & 63, r32 = lane & 31, hi = lane >> 5;
  bf16* V_lds = (bf16*)lds; bf16* K_lds = (bf16*)(lds + 3 * SHM_V);
  float* ws = (float*)(lds + 3 * SHM_V + 3 * SHM_K) + wid * 64; float* li_l = ws; float* al_l = ws + 32;
  float m_reg = 0.f, l_reg = 0; f32x16 o[4] = {}; bf16x8 qr[8]; f32x16 negm = {}; asm volatile("" : "+v"(negm));
  const TQ* Qw = Qb + (long)(wid * QBLK + r32) * LDQ + hi * 8;
#pragma unroll
  for (int d0 = 0; d0 < 8; ++d0) qr[d0] = SQ::tobf(SQ::ld8(Qw + d0 * 16));
  const int sr = tid >> 4, sc = (tid & 15) * 8, vst0 = v_st(sr, sc), vst1 = v_st(32 + sr, sc);
  const int vb0 = (int)(uintptr_t)V_lds + v_rd_base(lane);
  struct { typename St::T vs0, vs1, ks0, ks1; } sr_[SDEPTH];
#define SLOAD(i, k0) do { sr_[i].vs0 = St::ld8(&Vh[(long)((k0) + sr) * LDK + sc]); sr_[i].vs1 = St::ld8(&Vh[(long)((k0) + 32 + sr) * LDK + sc]); \
    sr_[i].ks0 = St::ld8(&Kh[(long)((k0) + sr) * LDK + sc]); sr_[i].ks1 = St::ld8(&Kh[(long)((k0) + 32 + sr) * LDK + sc]); } while (0)
#define SWRITE(off, i) do { *(bf16x8*)((char*)V_lds + (off) + vst0) = St::tobf(sr_[i].vs0);          \
    *(bf16x8*)((char*)V_lds + (off) + vst1) = St::tobf(sr_[i].vs1); int kc = sc * 2;               \
    *(bf16x8*)((char*)K_lds + (off) + KSWZ(sr, kc)) = St::tobf(sr_[i].ks0);                       \
    *(bf16x8*)((char*)K_lds + (off) + KSWZ(32 + sr, kc)) = St::tobf(sr_[i].ks1); } while (0)
#define SWAIT() do { if constexpr (SDEPTH == 2) asm volatile("s_waitcnt vmcnt(4)" ::: "memory"); else asm volatile("s_waitcnt vmcnt(0)" ::: "memory"); } while (0)
#define RESC(a) do { if (__any((a) < 1.f)) { if (hi == 0) al_l[r32] = (a); asm volatile("s_waitcnt lgkmcnt(0)" ::: "memory"); \
    for (int d = 0; d < 4; ++d) for (int r = 0; r < 16; ++r) o[d][r] *= al_l[crow(r, hi)]; } } while (0)
  f32x16 pA0, pA1, pB0, pB1; float alA, alB; bf16x8 pa0, pa1, pa2, pa3; const int NT = seq / KVBLK;
  constexpr int SE = 0, SO = SDEPTH - 1;
  SLOAD(SE, 0); asm volatile("s_waitcnt vmcnt(0)" ::: "memory"); SWRITE(0, SE); __syncthreads();
  qkt(pA0, pA1, K_lds, qr, negm, r32, hi); partialSM(pA0, pA1, m_reg, negm, alA);
  SLOAD(SO, KVBLK); if constexpr (SDEPTH == 2) { if (2 < NT) SLOAD(SE, 2 * KVBLK); }
  SWAIT(); SWRITE((int)SHM_V, SO); __syncthreads();
  int o_prv = 0, o_cur = (int)SHM_V, o_nxt = 2 * (int)SHM_V;
  if (wid >= 4) __builtin_amdgcn_s_setprio(1);
#define ROT3() do { const int t_ = o_prv; o_prv = o_cur; o_cur = o_nxt; o_nxt = t_; } while (0)
  for (int j = 1; j + 1 < NT; j += 2) {
    SBAR(); qkt_fin(pB0, pB1, (bf16*)((char*)K_lds + o_cur), qr, negm, r32, hi, pA0, pA1, alA, l_reg, pa0, pa1, pa2, pa3);
    SLOAD(SO, (j + SDEPTH) * KVBLK); SBAR();
    pv_d0(o, vb0 + o_prv, pa0, pa1, pa2, pa3); partialSM(pB0, pB1, m_reg, negm, alB);
    SWAIT(); SWRITE(o_nxt, SE);
    RESC(alB); __syncthreads(); ROT3();
    SBAR(); qkt_fin(pA0, pA1, (bf16*)((char*)K_lds + o_cur), qr, negm, r32, hi, pB0, pB1, alB, l_reg, pa0, pa1, pa2, pa3);
    if (SDEPTH == 1 || j + 3 < NT) SLOAD(SE, (j + 1 + SDEPTH) * KVBLK); SBAR();
    pv_d0(o, vb0 + o_prv, pa0, pa1, pa2, pa3); partialSM(pA0, pA1, m_reg, negm, alA);
    SWAIT(); SWRITE(o_nxt, SO);
    RESC(alA); __syncthreads(); ROT3();
  }
  SBAR(); qkt(pB0, pB1, (bf16*)((char*)K_lds + o_cur), qr, negm, r32, hi);
  finishSM(pA0, pA1, alA, l_reg, pa0, pa1, pa2, pa3); SBAR();
  pv_d0(o, vb0 + o_prv, pa0, pa1, pa2, pa3); partialSM(pB0, pB1, m_reg, negm, alB);
  RESC(alB);
  finishSM(pB0, pB1, alB, l_reg, pa0, pa1, pa2, pa3); SBAR();
  pv_d0(o, vb0 + o_cur, pa0, pa1, pa2, pa3);
  __builtin_amdgcn_s_setprio(0);
#undef ROT3
  if (hi == 0) li_l[r32] = l_reg; asm volatile("s_waitcnt lgkmcnt(0)" ::: "memory");
  float rli[16];
#pragma unroll
  for (int r = 0; r < 16; ++r) rli[r] = __builtin_amdgcn_rcpf(li_l[crow(r, hi)]);
  bf16* Ow = Ob + (long)(wid * QBLK) * LDO;
#pragma unroll
  for (int r = 0; r < 16; ++r) { int orow = crow(r, hi);
    for (int d0 = 0; d0 < 4; ++d0) Ow[(long)orow * LDO + d0 * 32 + r32] = __float2bfloat16(o[d0][r] * rli[r]); }
#undef SLOAD
#undef SWRITE
#undef SWAIT
#undef RESC
  __syncthreads();
}
#undef KSWZ
#undef SBAR
}
struct Args { const float* in[17]; float* out; unsigned char* ws; };

typedef const __attribute__((address_space(4))) Args* KArgs;
__device__ __forceinline__ KArgs kargs() { KArgs p = (KArgs)__builtin_amdgcn_kernarg_segment_ptr(); asm volatile("" : "+s"(p)); return p; }
struct Frame {
    LAS unsigned char* lds;
    int tid, lane, wave, vcu, G, gw, NGW;
    __device__ __forceinline__ void init(unsigned char* lds_) {
        lds = (LAS unsigned char*)lds_;
        tid = fresh_tid(); lane = tid & 63; wave = __builtin_amdgcn_readfirstlane(tid >> 6);
        G = gridDim.x; { const int bx = fresh_bid(); vcu = (G % 8 == 0) ? (bx % 8) * (G / 8) + bx / 8 : bx; }
        gw = vcu * NWAVES + wave; NGW = G * NWAVES;
    }
};
#define FIN(i) (ka->in[i])
#define FWS (ka->ws)

#define XB_TMO      128
#define XB_XCNT(j)  (256  + 64 * (j))
#define XB_XSUB(j)  (1280 + 64 * (j))
#define XB_XGEN(j)  (2304 + 64 * (j))
#define XB_TOP      3328
#define XB_TOPGEN   3392
#define XCD_BAR_WORDS 3456
#define XB_SPIN_CAP (1u << 18)

__device__ __forceinline__ unsigned xb_ld(unsigned* p)              { return __hip_atomic_load(p, __ATOMIC_RELAXED, __HIP_MEMORY_SCOPE_AGENT); }
__device__ __forceinline__ unsigned xb_add(unsigned* p, unsigned v) { return __hip_atomic_fetch_add(p, v, __ATOMIC_RELAXED, __HIP_MEMORY_SCOPE_AGENT); }
__device__ __forceinline__ unsigned xb_xcc_id() { return (unsigned)__builtin_amdgcn_s_getreg((3 << 11) | 20) & 0xFu; }
#define XB_SPIN(cond, bar) do { unsigned _sp = 0; while (cond) { __builtin_amdgcn_s_sleep(1); \
    if ((++_sp & 255u) == 0u) { if (xb_ld(&(bar)[XB_TMO])) break; if (_sp > XB_SPIN_CAP) { atomicAdd(&(bar)[XB_TMO], 1u); break; } } } } while (0)

struct XcdBarrier {
    unsigned* bar; unsigned x;
    volatile LAS unsigned* st;
};

__device__ __forceinline__ XcdBarrier xcd_barrier_post(unsigned* bar, volatile LAS unsigned* st) {
    XcdBarrier b; b.bar = bar; b.x = xb_xcc_id(); b.st = st;
    if (threadIdx.x == 0) (void)xb_add(&bar[XB_XCNT(b.x)], 1u);
    return b;
}
__device__ __forceinline__ void xcd_barrier_complete(unsigned* bar, unsigned x, unsigned& nloc, unsigned& nx) {
    const unsigned G = gridDim.x * gridDim.y * gridDim.z;
    unsigned sum, cnt, mine, sp = 0u;
    for (;;) {
        sum = 0u; cnt = 0u; mine = 0u;
#pragma unroll
        for (unsigned j = 0; j < 16; ++j) { const unsigned c = xb_ld(&bar[XB_XCNT(j)]); sum += c; cnt += (c > 0u) ? 1u : 0u; mine = (j == x) ? c : mine; }
        if (sum == G) break;
        __builtin_amdgcn_s_sleep(1);
        if ((++sp & 255u) == 0u) { if (xb_ld(&bar[XB_TMO])) break; if (sp > XB_SPIN_CAP) { atomicAdd(&bar[XB_TMO], 1u); break; } }
    }
    nloc = mine > 0u ? mine : 1u; nx = cnt > 0u ? cnt : 1u;
}

__device__ __forceinline__ void xcd_barrier(const XcdBarrier& b) {
    asm volatile("s_waitcnt vmcnt(0)" ::: "memory");
    __syncthreads();
    if (threadIdx.x == 0) {
        unsigned* bar = b.bar;
        __builtin_amdgcn_s_waitcnt(0);
        unsigned nloc = b.st[0], nx = b.st[1];
        if (nloc == 0u) { xcd_barrier_complete(bar, b.x, nloc, nx); b.st[0] = nloc; b.st[1] = nx; }
        const unsigned old = xb_add(&bar[XB_XSUB(b.x)], 1u);
        const unsigned gen = old / nloc;
        if (old + 1u == (gen + 1u) * nloc) {
            __builtin_amdgcn_fence(__ATOMIC_RELEASE, "agent");
            asm volatile("s_waitcnt vmcnt(0)" ::: "memory");
            const unsigned og = xb_add(&bar[XB_TOP], 1u);
            const unsigned tg = og / nx;
            if (og + 1u == (tg + 1u) * nx) xb_add(&bar[XB_TOPGEN], 1u);
            else XB_SPIN(xb_ld(&bar[XB_TOPGEN]) == tg, bar);
            __builtin_amdgcn_fence(__ATOMIC_ACQUIRE, "agent");
            xb_add(&bar[XB_XGEN(b.x)], 1u);
            asm volatile("s_waitcnt vmcnt(0)" ::: "memory");
        } else {
            XB_SPIN(xb_ld(&bar[XB_XGEN(b.x)]) == gen, bar);
            __builtin_amdgcn_fence(__ATOMIC_ACQUIRE, "agent");
            asm volatile("s_waitcnt vmcnt(0)" ::: "memory");
        }
    }
    __syncthreads();
}

constexpr int XB_LDS_OFF = RING_BYTES + 64;
constexpr int XB_WORD0 = 1024;
__device__ __forceinline__ void grid_bar(unsigned char* lds_) {
    KArgs ka = kargs();
    XcdBarrier b; b.bar = (unsigned*)(ka->ws + WS_CTL) + XB_WORD0; b.x = xb_xcc_id(); b.st = (volatile LAS unsigned*)((LAS unsigned char*)lds_ + XB_LDS_OFF);
    xcd_barrier(b);
}

__device__ __forceinline__ void p0_transpose_item(const float* W, int K, int N, bf16raw* WT, LAS float* scr, int kb, int nb, int lane) {
    const int k0 = 64 * kb, n0 = 32 * nb;
#pragma unroll 8
    for (int i = 0; i < 32; ++i) { const int kk = 2 * i + (lane >> 5); scr[kk * 33 + (lane & 31)] = W[(size_t)(k0 + kk) * N + n0 + (lane & 31)]; }
    asm volatile("s_waitcnt lgkmcnt(0)" ::: "memory");
    const int c = lane & 7;
#pragma unroll
    for (int j = 0; j < 4; ++j) { const int n = (lane >> 3) + 8 * j; const LAS float* s = scr + (8 * c) * 33 + n;
        v4u o; o.x = pk2(s[0 * 33], s[1 * 33]); o.y = pk2(s[2 * 33], s[3 * 33]); o.z = pk2(s[4 * 33], s[5 * 33]); o.w = pk2(s[6 * 33], s[7 * 33]);
        *(v4u*)(WT + (size_t)(n0 + n) * K + k0 + 8 * c) = o; }
    asm volatile("s_waitcnt lgkmcnt(0)" ::: "memory");
}
__device__ __forceinline__ void p0_fold_item(const float* wpool, const float* ps, const float* wout, bf16raw* WT, int it, int lane) {
    const int nb = it & 63, ct = it >> 6, g = ct >> 3, c0 = (ct & 7) * 16, n = nb * 32 + (lane & 31), ch = lane >> 5;
    const float* wp = wpool + ((size_t)g * 128 + c0 + ch * 8) * 128;
    const float* wo = wout + (size_t)(1024 + g * 128) * 2048 + n;
    const float* psg = ps + g * 128;
    float acc[8];
#pragma unroll
    for (int i = 0; i < 8; ++i) acc[i] = 0.f;
#pragma unroll 2
    for (int e4 = 0; e4 < 32; ++e4) {
        const v4f pv = *(const v4f*)(psg + 4 * e4);
        const float w0 = wo[(size_t)(4 * e4 + 0) * 2048] * pv.x, w1 = wo[(size_t)(4 * e4 + 1) * 2048] * pv.y, w2 = wo[(size_t)(4 * e4 + 2) * 2048] * pv.z, w3 = wo[(size_t)(4 * e4 + 3) * 2048] * pv.w;
#pragma unroll
        for (int i = 0; i < 8; ++i) { const v4f p = *(const v4f*)(wp + i * 128 + 4 * e4); acc[i] += p.x * w0 + p.y * w1 + p.z * w2 + p.w * w3; }
    }
    *(v4u*)(WT + (size_t)n * 2048 + 1024 + g * 128 + c0 + ch * 8) = pack8(acc);
}

__device__ __forceinline__ void p0_prologue(unsigned char* lds_) {
    KArgs ka = kargs(); Frame F; F.init(lds_);
    LAS float* ACT = (LAS float*)F.lds;
    LAS float* PART = (LAS float*)(F.lds + 32768);
    for (int idx = F.tid; idx < 3 * 2048; idx += NTHREADS) { const int s = idx >> 11, d = idx & 2047; const float v = s < 2 ? FIN(1)[s * 2048 + d] : FIN(3)[d]; ACT[idx] = v / (1.f + expf(-v)); }
    __syncthreads();
    float* mod = (float*)(FWS + WS_MOD);
    for (int item = blockIdx.x; item < 256; item += F.G) {
        const int col0 = item * 96, l = col0 / 12288, cl = col0 % 12288;
        if (F.tid < 504) {
            const int cq = F.tid % 24, rg = F.tid / 24; const float* wp = FIN(4) + (size_t)l * 2048 * 12288 + cl + cq * 4;
            v4f a0 = {0.f, 0.f, 0.f, 0.f}, a1 = a0, a2 = a0;
#pragma unroll 7
            for (int d = rg; d < 2048; d += 21) { const v4f w = *(const v4f*)(wp + (size_t)d * 12288); a0 += w * ACT[d]; a1 += w * ACT[2048 + d]; a2 += w * ACT[4096 + d]; }
            *(LAS v4f*)(PART + (rg * 3 + 0) * 96 + cq * 4) = a0; *(LAS v4f*)(PART + (rg * 3 + 1) * 96 + cq * 4) = a1; *(LAS v4f*)(PART + (rg * 3 + 2) * 96 + cq * 4) = a2;
        }
        __syncthreads();
        if (F.tid < 288) { const int s = F.tid / 96, cc = F.tid % 96; float sum = FIN(5)[l * 12288 + cl + cc];
            for (int rg = 0; rg < 21; ++rg) sum += PART[(rg * 3 + s) * 96 + cc];
            mod[(size_t)(l * 3 + s) * 12288 + cl + cc] = sum; }
        __syncthreads();
    }
    { bf16raw* Xb = (bf16raw*)(FWS + WS_X); const int gt = F.vcu * NTHREADS + F.tid, NT_ = F.G * NTHREADS;
      for (int i = gt; i < NB * CTX * 256; i += NT_) { const int row = i >> 8, c8 = i & 255, b = row >> 8, j = row & 255;
          const v4f a0 = *(const v4f*)(FIN(2) + (size_t)row * 2048 + c8 * 8), a1 = *(const v4f*)(FIN(2) + (size_t)row * 2048 + c8 * 8 + 4);
          v4u w; w.x = pk2(a0.x, a0.y); w.y = pk2(a0.z, a0.w); w.z = pk2(a1.x, a1.y); w.w = pk2(a1.z, a1.w);
          *(v4u*)(Xb + ((size_t)b * RPB + j) * 2048 + c8 * 8) = w; } }
    { float* rope = (float*)(FWS + WS_ROPE); const int gt = F.vcu * NTHREADS + F.tid;
      if (gt < 192 * 32) { const int p = gt >> 5, f = gt & 31; const float inv = powf(10000.0f, -(float)f / 32.0f);
          if (p < 128) { const float ang = (float)p * inv; rope[p * 32 + f] = cosf(ang); rope[4096 + p * 32 + f] = sinf(ang); }
          else { const float ang = (float)(p - 128) * inv; rope[8192 + (p - 128) * 32 + f] = cosf(ang); rope[8192 + 2048 + (p - 128) * 32 + f] = sinf(ang); } } }
    LAS float* scr = (LAS float*)(F.lds + F.wave * 16384);
    constexpr int I_IN = 32 * 112, I_OUT = 24 * 64, I_F1 = 32 * 256, I_F2 = 128 * 64, I_FOLD = 32 * 64, I_L = I_IN + I_OUT + I_F1 + I_F2 + I_FOLD;
    for (int it = F.gw; it < 2 * I_L; it += F.NGW) {
        const int l = it / I_L; int r = it % I_L; unsigned char* wl = FWS + WS_W + (size_t)l * WL_BYTES;
        if (r < I_IN) { p0_transpose_item(FIN(8) + (size_t)l * 2048 * 3584, 2048, 3584, (bf16raw*)(wl + WO_IN), scr, r / 112, r % 112, F.lane); continue; } r -= I_IN;
        if (r < I_OUT) { int kb = r / 64; kb = kb < 16 ? kb : kb + 8; p0_transpose_item(FIN(14) + (size_t)l * 2048 * 2048, 2048, 2048, (bf16raw*)(wl + WO_OUT), scr, kb, r % 64, F.lane); continue; } r -= I_OUT;
        if (r < I_F1) { p0_transpose_item(FIN(15) + (size_t)l * 2048 * 8192, 2048, 8192, (bf16raw*)(wl + WO_FF1), scr, r / 256, r % 256, F.lane); continue; } r -= I_F1;
        if (r < I_F2) { p0_transpose_item(FIN(16) + (size_t)l * 8192 * 2048, 8192, 2048, (bf16raw*)(wl + WO_FF2), scr, r / 64, r % 64, F.lane); continue; } r -= I_F2;
        p0_fold_item(FIN(11) + (size_t)l * 4 * 128 * 128, FIN(12) + (size_t)l * 512, FIN(14) + (size_t)l * 2048 * 2048, (bf16raw*)(wl + WO_OUT), r, F.lane);
    }
}

__device__ __forceinline__ void norm_phase(unsigned char* lds_, int l, int which  , int src_in, int skip_ctx, int nslab, const float* slab, int gate_off, int write_x) {
    KArgs ka = kargs(); Frame F; F.init(lds_);
    LAS float* GS = (LAS float*)F.lds; LAS float* SH = GS + 3 * 2048;
    const float* mod = (const float*)(FWS + WS_MOD) + (size_t)l * 3 * 12288; const float* g = (which == 1 ? FIN(6) : FIN(7)) + l * 2048;
    const int shc = which == 1 ? 0 : 3, scc = shc + 1;
    for (int idx = F.tid; idx < 3 * 2048; idx += NTHREADS) { const int s = idx >> 11, c = idx & 2047; GS[idx] = g[c] * (1.f + mod[s * 12288 + scc * 2048 + c]); SH[idx] = mod[s * 12288 + shc * 2048 + c]; }
    __syncthreads();
    bf16raw* Xb = (bf16raw*)(FWS + WS_X); bf16raw* H = (bf16raw*)(FWS + WS_H);
    const float* mod0 = (const float*)(FWS + WS_MOD);
    constexpr int NR = 4;
    for (int r0 = F.gw; r0 < MROWS; r0 += NR * F.NGW) {
        float v[NR][4][8]; int sidx[NR]; bool act[NR];
#pragma unroll
        for (int q = 0; q < NR; ++q) {
            const int r = r0 + q * F.NGW; const int rr = r < MROWS ? r : r0; const int b = rr / RPB, j = rr % RPB; const bool isctx = j < CTX;
            act[q] = r < MROWS && !(isctx && skip_ctx); sidx[q] = isctx ? 2 : b;
            if (src_in) { const float* xr = isctx ? FIN(2) + ((size_t)b * CTX + j) * 2048 : FIN(0) + ((size_t)b * SEQ + (j - CTX)) * 2048;
#pragma unroll
                for (int jj = 0; jj < 4; ++jj) { const v4f a0 = *(const v4f*)(xr + F.lane * 8 + 512 * jj), a1 = *(const v4f*)(xr + F.lane * 8 + 512 * jj + 4);
                    v[q][jj][0] = a0.x; v[q][jj][1] = a0.y; v[q][jj][2] = a0.z; v[q][jj][3] = a0.w; v[q][jj][4] = a1.x; v[q][jj][5] = a1.y; v[q][jj][6] = a1.z; v[q][jj][7] = a1.w; } }
            else {
#pragma unroll
                for (int jj = 0; jj < 4; ++jj) unpack8(*(const v4u*)(Xb + (size_t)rr * 2048 + F.lane * 8 + 512 * jj), v[q][jj]); }
            if (nslab > 0 && isctx && act[q]) {
                const float* sp = slab + ((size_t)b * CTX + j) * 2048 + F.lane * 8; const float* gp = mod0 + gate_off + F.lane * 8;
                v4f sacc[4][2];
#pragma unroll
                for (int jj = 0; jj < 4; ++jj) { sacc[jj][0] = (v4f){0.f, 0.f, 0.f, 0.f}; sacc[jj][1] = sacc[jj][0]; }
#pragma unroll 2
                for (int k = 0; k < nslab; ++k) {
#pragma unroll
                    for (int jj = 0; jj < 4; ++jj) { sacc[jj][0] += *(const v4f*)(sp + (size_t)k * 512 * 2048 + 512 * jj); sacc[jj][1] += *(const v4f*)(sp + (size_t)k * 512 * 2048 + 512 * jj + 4); } }
#pragma unroll
                for (int jj = 0; jj < 4; ++jj) { const v4f g0 = *(const v4f*)(gp + 512 * jj), g1 = *(const v4f*)(gp + 512 * jj + 4);
                    v[q][jj][0] += g0.x * sacc[jj][0].x; v[q][jj][1] += g0.y * sacc[jj][0].y; v[q][jj][2] += g0.z * sacc[jj][0].z; v[q][jj][3] += g0.w * sacc[jj][0].w;
                    v[q][jj][4] += g1.x * sacc[jj][1].x; v[q][jj][5] += g1.y * sacc[jj][1].y; v[q][jj][6] += g1.z * sacc[jj][1].z; v[q][jj][7] += g1.w * sacc[jj][1].w;
                    if (write_x) *(v4u*)(Xb + (size_t)rr * 2048 + F.lane * 8 + 512 * jj) = pack8(v[q][jj]); }
            }
        }
#pragma unroll
        for (int q = 0; q < NR; ++q) {
            float ss = 0.f;
#pragma unroll
            for (int jj = 0; jj < 4; ++jj)
#pragma unroll
                for (int i = 0; i < 8; ++i) ss += v[q][jj][i] * v[q][jj][i];
            const float rstd = 1.f / sqrtf(wave_sum(ss) * (1.f / 2048.f) + EPS);
            if (act[q]) { bf16raw* hr = H + (size_t)(r0 + q * F.NGW) * 2048; const int s = sidx[q];
#pragma unroll
                for (int jj = 0; jj < 4; ++jj) { const int c = F.lane * 8 + 512 * jj;
                    const v4f g0 = *(const LAS v4f*)(GS + s * 2048 + c), g1 = *(const LAS v4f*)(GS + s * 2048 + c + 4), h0 = *(const LAS v4f*)(SH + s * 2048 + c), h1 = *(const LAS v4f*)(SH + s * 2048 + c + 4);
                    float o[8]; o[0] = v[q][jj][0] * rstd * g0.x + h0.x; o[1] = v[q][jj][1] * rstd * g0.y + h0.y; o[2] = v[q][jj][2] * rstd * g0.z + h0.z; o[3] = v[q][jj][3] * rstd * g0.w + h0.w;
                    o[4] = v[q][jj][4] * rstd * g1.x + h1.x; o[5] = v[q][jj][5] * rstd * g1.y + h1.y; o[6] = v[q][jj][6] * rstd * g1.z + h1.z; o[7] = v[q][jj][7] * rstd * g1.w + h1.w;
                    *(v4u*)(hr + c) = pack8(o); } }
        }
    }
    __syncthreads();
}

constexpr float QSCALE = 0.088388347648318440f * 1.4426950408889634f;
struct RopeCS { v4f c0, c1, s0, s1; };
__device__ __forceinline__ void normrope8(float* x, const v4f g0, const v4f g1, const RopeCS& rc, bool dorope, int lane) {
    const int sub = lane & 15, quarter = sub >> 2;
    float ss = 0.f;
#pragma unroll
    for (int i = 0; i < 8; ++i) ss += x[i] * x[i];
    ss += __shfl_xor(ss, 1); ss += __shfl_xor(ss, 2); ss += __shfl_xor(ss, 4); ss += __shfl_xor(ss, 8);
    const float rstd = 1.f / sqrtf(ss * (1.f / 128.f) + EPS);
    x[0] *= rstd * g0.x; x[1] *= rstd * g0.y; x[2] *= rstd * g0.z; x[3] *= rstd * g0.w; x[4] *= rstd * g1.x; x[5] *= rstd * g1.y; x[6] *= rstd * g1.z; x[7] *= rstd * g1.w;
    float p[8];
#pragma unroll
    for (int i = 0; i < 8; ++i) p[i] = __shfl_xor(x[i], 4);
    if (dorope) {
        const float cs[8] = {rc.c0.x, rc.c0.y, rc.c0.z, rc.c0.w, rc.c1.x, rc.c1.y, rc.c1.z, rc.c1.w}, sn[8] = {rc.s0.x, rc.s0.y, rc.s0.z, rc.s0.w, rc.s1.x, rc.s1.y, rc.s1.z, rc.s1.w};
        const float sg = (quarter & 1) ? 1.f : -1.f;
#pragma unroll
        for (int i = 0; i < 8; ++i) x[i] = x[i] * cs[i] + sg * p[i] * sn[i];
    }
}
__device__ __forceinline__ void a2_phase(unsigned char* lds_, int l, int last) {
    KArgs ka = kargs(); Frame F; F.init(lds_);
    bf16raw* P = (bf16raw*)(FWS + WS_P); bf16raw* CAT = (bf16raw*)(FWS + WS_CAT); bf16raw* KV = (bf16raw*)(FWS + WS_KV); bf16raw* QN = (bf16raw*)(FWS + WS_QN);
    const float* rope = (const float*)(FWS + WS_ROPE);
    const int lane = F.lane, sub = lane & 15, quarter = sub >> 2, f0 = (sub & 3) * 8;
    const v4f qg0 = *(const v4f*)(FIN(9) + l * 128 + sub * 8), qg1 = *(const v4f*)(FIN(9) + l * 128 + sub * 8 + 4);
    const v4f kg0 = *(const v4f*)(FIN(10) + l * 128 + sub * 8), kg1 = *(const v4f*)(FIN(10) + l * 128 + sub * 8 + 4);
    const float* cw = FIN(13) + (size_t)l * 3 * 512 + lane * 8;
    v4f cwv[3][2];
#pragma unroll
    for (int jj = 0; jj < 3; ++jj) { cwv[jj][0] = *(const v4f*)(cw + jj * 512); cwv[jj][1] = *(const v4f*)(cw + jj * 512 + 4); }
    const int gi = lane >> 4, lo = 1 << gi;
    for (int r = F.gw; r < MROWS; r += F.NGW) {
        const int b = r / RPB, j = r % RPB; const bool isctx = j < CTX; const int pos = j - CTX, prow = isctx ? 0 : pos >> 6, pcol = isctx ? 0 : pos & 63;
        const int t = isctx ? j : pos, n = isctx ? CTX : SEQ; const bool full = !(isctx && last);
        bf16raw* Pr = P + (size_t)r * INW;
        const v4u kvraw = *(const v4u*)(Pr + K_OFF + lane * 8);
        RopeCS rc;
        { const int co = quarter < 2 ? prow * 32 + f0 : 8192 + pcol * 32 + f0, so = co + (quarter < 2 ? 4096 : 2048);
          rc.c0 = *(const v4f*)(rope + co); rc.c1 = *(const v4f*)(rope + co + 4); rc.s0 = *(const v4f*)(rope + so); rc.s1 = *(const v4f*)(rope + so + 4); }
        if (full) {
            const v4u q0 = *(const v4u*)(Pr + lane * 8), q1 = *(const v4u*)(Pr + 512 + lane * 8);
            v4u pw[16];
            const bf16raw* pb = P + (size_t)(r - t) * INW + POOL_OFF + lane * 8;
#pragma unroll
            for (int d = 0; d < 16; ++d) { int tt = t - 8 + d; tt = tt < 0 ? 0 : (tt > n - 1 ? n - 1 : tt); pw[d] = *(const v4u*)(pb + (size_t)tt * INW); }
            const v4u cbr = *(const v4u*)(Pr + CB_OFF + lane * 8);
            v4u ccr[3], cvr[3];
#pragma unroll
            for (int jj = 0; jj < 3; ++jj) { int tt = t + jj - 1; tt = tt < 0 ? 0 : (tt > n - 1 ? n - 1 : tt); const bf16raw* p2 = P + (size_t)(r - t + tt) * INW + lane * 8; ccr[jj] = *(const v4u*)(p2 + CC_OFF); cvr[jj] = *(const v4u*)(p2 + CV_OFF); }
            { float x[8]; unpack8(q0, x); normrope8(x, qg0, qg1, rc, !isctx, lane);
#pragma unroll
              for (int i = 0; i < 8; ++i) x[i] *= QSCALE;
              *(v4u*)(QN + (size_t)r * 1024 + lane * 8) = pack8(x); }
            { float x[8]; unpack8(q1, x); normrope8(x, qg0, qg1, rc, !isctx, lane);
#pragma unroll
              for (int i = 0; i < 8; ++i) x[i] *= QSCALE;
              *(v4u*)(QN + (size_t)r * 1024 + 512 + lane * 8) = pack8(x); }
            { float acc[8], me[8];
#pragma unroll
              for (int i = 0; i < 8; ++i) acc[i] = 0.f;
              int cnt = 0;
#pragma unroll
              for (int d = 0; d < 16; ++d) { const int dt = d - 8, tt = t + dt; const bool ok = dt >= -lo && dt < lo && tt >= 0 && tt < n; float x[8]; unpack8(pw[d], x); const float m = ok ? 1.f : 0.f; cnt += ok ? 1 : 0;
#pragma unroll
                  for (int i = 0; i < 8; ++i) acc[i] += m * x[i]; }
              unpack8(pw[8], me); const float ic = 1.f / (float)cnt;
#pragma unroll
              for (int i = 0; i < 8; ++i) acc[i] = acc[i] * ic - me[i];
              *(v4u*)(CAT + (size_t)r * 2048 + 1024 + lane * 8) = pack8(acc); }
            { float cb[8], acc[8]; unpack8(cbr, cb);
#pragma unroll
              for (int i = 0; i < 8; ++i) acc[i] = 0.f;
#pragma unroll
              for (int jj = 0; jj < 3; ++jj) { const int tt = t + jj - 1; const float m = (tt >= 0 && tt < n) ? 1.f : 0.f; float a[8], v[8]; unpack8(ccr[jj], a); unpack8(cvr[jj], v);
                  const float ww[8] = {cwv[jj][0].x, cwv[jj][0].y, cwv[jj][0].z, cwv[jj][0].w, cwv[jj][1].x, cwv[jj][1].y, cwv[jj][1].z, cwv[jj][1].w};
#pragma unroll
                  for (int i = 0; i < 8; ++i) acc[i] += m * a[i] * v[i] * ww[i]; }
#pragma unroll
              for (int i = 0; i < 8; ++i) acc[i] *= cb[i];
              *(v4u*)(CAT + (size_t)r * 2048 + 1536 + lane * 8) = pack8(acc); }
        }
        { float x[8]; unpack8(kvraw, x); normrope8(x, kg0, kg1, rc, !isctx, lane); const v4u kn = pack8(x); const int hd = (lane >> 4) & 1;
          bf16raw* dst = KV + (lane < 32 ? (size_t)0 : (size_t)NB * 2 * RPB * 128) + ((size_t)(b * 2 + hd) * RPB + j) * 128 + sub * 8; *(v4u*)dst = lane < 32 ? kn : kvraw; }
    }
}

__device__ __forceinline__ void attn_phase(unsigned char* lds_, int last) {
    KArgs ka = kargs(); Frame F; F.init(lds_); char* lds = (char*)lds_;
    const att::bf16* QN = (const att::bf16*)(FWS + WS_QN); const att::bf16* KV = (const att::bf16*)(FWS + WS_KV); att::bf16* CAT = (att::bf16*)(FWS + WS_CAT);
    const int nlat = 512, nctx = last ? 0 : 16;
    for (int i = 0;; ++i) {
        const int idx = i * F.G + F.vcu; if (idx >= nlat + nctx) break;
        int b, h, qrow, seq;
        if (idx < nlat) { const int per = F.G >= 4 ? F.G / 4 : 1; int u;
            if (F.G == 256) { const int combo = F.vcu / per, k = F.vcu % per; u = combo * 128 + k + i * per; } else u = idx;
            const int combo = u >> 7, w = u & 127; b = combo >> 1; h = (combo & 1) * 4 + (w >> 5); qrow = b * RPB + CTX + (w & 31) * 256; seq = RPB; }
        else { const int e = idx - nlat; b = e >> 3; h = e & 7; qrow = b * RPB; seq = CTX; }
        const int kvh = h >> 2;
        att::attn_dense_body<1024, 128, 2048>(QN + (size_t)qrow * 1024 + h * 128, KV + (size_t)(b * 2 + kvh) * RPB * 128, KV + (size_t)NB * 2 * RPB * 128 + (size_t)(b * 2 + kvh) * RPB * 128,
                                             CAT + (size_t)qrow * 2048 + h * 128, seq, lds);
    }
}

#ifndef REP_PREP
#define REP_PREP 1
#endif
#ifndef REP_NORM
#define REP_NORM 1
#endif
#ifndef REP_ATTN
#define REP_ATTN 1
#endif
#ifndef REP_INPROJ
#define REP_INPROJ 1
#endif
#ifndef SPLITK_CTX
#define SPLITK_CTX 1
#endif
#ifndef REP_A2
#define REP_A2 1
#endif
#ifndef REP_BAR
#define REP_BAR 0
#endif
#ifndef REP_OUTPROJ
#define REP_OUTPROJ 1
#endif
#ifndef REP_FF2
#define REP_FF2 1
#endif
#ifndef REP_FF1
#define REP_FF1 1
#endif
__global__ void __launch_bounds__(NTHREADS, 2) fwd_megakernel(Args args) {
    extern __shared__ __attribute__((aligned(16))) unsigned char lds[];
    cg::grid_group grid = cg::this_grid();
    if (threadIdx.x < 2) ((LAS unsigned*)((LAS unsigned char*)lds + XB_LDS_OFF))[threadIdx.x] = 0u;
    __syncthreads();
    if (blockIdx.x == 0) { KArgs ka = kargs(); unsigned* bw = (unsigned*)(ka->ws + WS_CTL) + XB_WORD0; for (int i = threadIdx.x; i < XCD_BAR_WORDS; i += NTHREADS) bw[i] = 0u; }
    for (int rep_ = 0; rep_ < REP_PREP; ++rep_) { p0_prologue(lds); __syncthreads(); }
    grid.sync();
    { KArgs ka = kargs(); (void)xcd_barrier_post((unsigned*)(ka->ws + WS_CTL) + XB_WORD0, (volatile LAS unsigned*)((LAS unsigned char*)lds + XB_LDS_OFF)); }
#pragma unroll 1
    for (int l = 0; l < 2; ++l) {
        const int last = l == 1;
        for (int rep_ = 0; rep_ < REP_NORM; ++rep_) norm_phase(lds, l, 1, l == 0, 0, (SPLITK_CTX && l == 1) ? 16 : 0, (const float*)kargs()->out, (0 * 3 + 2) * 12288 + 5 * 2048, 0);
        grid_bar(lds);
        for (int rep_ = 0; rep_ < REP_INPROJ; ++rep_) {
            KArgs ka = kargs(); unsigned char* wl = FWS + WS_W + (size_t)l * WL_BYTES;
            pg8::Gemm g{(const pg8::bf16_t*)(FWS + WS_H), (const pg8::bf16_t*)(wl + WO_IN), MROWS, INW, DM, DM}; pg8::TileOrder S; S.init(INW, gridDim.x, fresh_bid(), last ? 2 : 0);
            pg8::EpiBf16<0> E{(pg8::bf16_t*)(FWS + WS_P), INW};
            pg8::gemm_phase<pg8::EpiBf16<0>, pg8::TileOrder, true, true>((LAS unsigned char*)lds, g, S, E);
        }
        grid_bar(lds);
        for (int rep_ = 0; rep_ < REP_A2; ++rep_) a2_phase(lds, l, last);
        grid_bar(lds);
        for (int rep_ = 0; rep_ < REP_ATTN; ++rep_) attn_phase(lds, last);
        grid_bar(lds);
        for (int rep_ = 0; rep_ < REP_BAR; ++rep_) grid_bar(lds);
        for (int rep_ = 0; rep_ < REP_OUTPROJ; ++rep_) {
            KArgs ka = kargs(); unsigned char* wl = FWS + WS_W + (size_t)l * WL_BYTES; pg8::bf16_t* X = (pg8::bf16_t*)(FWS + WS_X); const float* mod = (const float*)(FWS + WS_MOD);
            pg8::Gemm g{(const pg8::bf16_t*)(FWS + WS_CAT), (const pg8::bf16_t*)(wl + WO_OUT), MROWS, DM, DM, DM}; pg8::TileOrder S; S.init(DM, gridDim.x, fresh_bid(), (SPLITK_CTX || last) ? 1 : 0);
            pg8::EpiGateRes E{mod + (size_t)l * 3 * 12288 + 2 * 2048, FIN(0), FIN(2), X, ka->out, l == 0 ? 1 : 0, rep_ + 1 < REP_OUTPROJ ? 1 : 0};
            pg8::gemm_phase<pg8::EpiGateRes, pg8::TileOrder, true, true>((LAS unsigned char*)lds, g, S, E);
        }
        if (SPLITK_CTX && !last) {
            KArgs ka = kargs(); unsigned char* wl = FWS + WS_W + (size_t)l * WL_BYTES;
            const int c = fresh_bid(), tile = c >> 3, kc = c & 7;
            pg8::Gemm g{(const pg8::bf16_t*)(FWS + WS_CAT) + kc * 256, (const pg8::bf16_t*)(wl + WO_OUT) + kc * 256, MROWS, DM, 256, DM};
            pg8::OneUnit S{(tile >> 3) * 33, tile & 7, c < 128};
            pg8::EpiSlab E{ka->out + (size_t)(16 + kc) * 512 * 2048};
            pg8::gemm_phase<pg8::EpiSlab, pg8::OneUnit, false, true>((LAS unsigned char*)lds, g, S, E);
        }
        grid_bar(lds);
        for (int rep_ = 0; rep_ < REP_NORM; ++rep_) norm_phase(lds, l, 2, 0, last, (SPLITK_CTX && l == 0) ? 8 : 0, (const float*)kargs()->out + (size_t)16 * 512 * 2048, (0 * 3 + 2) * 12288 + 2 * 2048, 1);
        grid_bar(lds);
        for (int rep_ = 0; rep_ < REP_FF1; ++rep_) {
            KArgs ka = kargs(); unsigned char* wl = FWS + WS_W + (size_t)l * WL_BYTES;
            pg8::Gemm g{(const pg8::bf16_t*)(FWS + WS_H), (const pg8::bf16_t*)(wl + WO_FF1), MROWS, DFF, DM, DM}; pg8::TileOrder S; S.init(DFF, gridDim.x, fresh_bid(), last ? 1 : 0);
            pg8::EpiBf16<2> E{(pg8::bf16_t*)(FWS + WS_U), DFF};
            pg8::gemm_phase<pg8::EpiBf16<2>, pg8::TileOrder, true, true>((LAS unsigned char*)lds, g, S, E);
        }
        grid_bar(lds);
        for (int rep_ = 0; rep_ < REP_FF2; ++rep_) {
            KArgs ka = kargs(); unsigned char* wl = FWS + WS_W + (size_t)l * WL_BYTES; pg8::bf16_t* X = (pg8::bf16_t*)(FWS + WS_X); const float* mod = (const float*)(FWS + WS_MOD);
            pg8::Gemm g{(const pg8::bf16_t*)(FWS + WS_U), (const pg8::bf16_t*)(wl + WO_FF2), MROWS, DM, DFF, DFF}; pg8::TileOrder S; S.init(DM, gridDim.x, fresh_bid(), (SPLITK_CTX || last) ? 1 : 0);
            pg8::EpiGateRes E{mod + (size_t)l * 3 * 12288 + 5 * 2048, FIN(0), FIN(2), X, ka->out, 0, (rep_ + 1 < REP_FF2) ? 1 : last};
            pg8::gemm_phase<pg8::EpiGateRes, pg8::TileOrder, true, true>((LAS unsigned char*)lds, g, S, E);
        }
        if (SPLITK_CTX && !last) {
            KArgs ka = kargs(); unsigned char* wl = FWS + WS_W + (size_t)l * WL_BYTES;
            const int c = fresh_bid(), tile = c >> 4, kc = c & 15;
            pg8::Gemm g{(const pg8::bf16_t*)(FWS + WS_U) + kc * 512, (const pg8::bf16_t*)(wl + WO_FF2) + kc * 512, MROWS, DM, 512, DFF};
            pg8::OneUnit S{(tile >> 3) * 33, tile & 7, c < 256};
            pg8::EpiSlab E{ka->out + (size_t)kc * 512 * 2048};
            pg8::gemm_phase<pg8::EpiSlab, pg8::OneUnit, false, true>((LAS unsigned char*)lds, g, S, E);
        }
        if (!last) grid_bar(lds);
    }
}

extern "C" void kernel_launch(void* const* d_in, const int* in_sizes, int n_in, void* d_out, int out_size, void* d_ws, size_t ws_size, hipStream_t stream) {
    static int grid = 0;
    if (grid == 0) {
        if (n_in != 17 || in_sizes[0] != NB * SEQ * DM || out_size != NB * SEQ * DM || ws_size < WS_END) {
            fprintf(stderr, "kernel_launch: unexpected shapes (n_in %d, in0 %d, out %d, ws %zu; need ws >= %zu)\n", n_in, n_in > 0 ? in_sizes[0] : -1, out_size, ws_size, (size_t)WS_END); grid = -1; return; }
        int dev = 0, cus = 0, per_cu = 0;
        if (hipGetDevice(&dev) != hipSuccess || hipDeviceGetAttribute(&cus, hipDeviceAttributeMultiprocessorCount, dev) != hipSuccess) { grid = -1; return; }
        if (hipFuncSetAttribute((const void*)fwd_megakernel, hipFuncAttributeMaxDynamicSharedMemorySize, LDS_BYTES) != hipSuccess) { fprintf(stderr, "kernel_launch: hipFuncSetAttribute failed\n"); grid = -1; return; }
        if (hipOccupancyMaxActiveBlocksPerMultiprocessor(&per_cu, (const void*)fwd_megakernel, NTHREADS, LDS_BYTES) != hipSuccess || per_cu < 1) { fprintf(stderr, "kernel_launch: occupancy query gave %d\n", per_cu); per_cu = 1; }
        (void)hipGetLastError();
        grid = cus * per_cu;
    }
    if (grid < 0) return;
    Args a{};
    for (int i = 0; i < 17; ++i) a.in[i] = (const float*)d_in[i];
    a.out = (float*)d_out; a.ws = (unsigned char*)d_ws;
    void* params[] = {&a};
    const hipError_t e = hipLaunchCooperativeKernel((const void*)fwd_megakernel, dim3(grid), dim3(NTHREADS), params, LDS_BYTES, stream);
    if (e != hipSuccess) fprintf(stderr, "kernel_launch: cooperative launch failed: %s (grid %d)\n", hipGetErrorString(e), grid);
}
```

```cpp
#include <hip/hip_runtime.h>
#include <hip/hip_bf16.h>
#include <hip/hip_cooperative_groups.h>
#include <cstdio>
#include <cstdint>
namespace cg = cooperative_groups;

constexpr int DM = 2048, NB = 2, SEQ = 8192, CTX = 256, RPB = SEQ + CTX, MROWS = NB * RPB;
constexpr int INW = 3584, DFF = 8192, HD = 128, TPB = RPB / 256;
constexpr int Q_OFF = 0, K_OFF = 1024, V_OFF = 1280, POOL_OFF = 1536, CB_OFF = 2048, CC_OFF = 2560, CV_OFF = 3072;
constexpr float EPS = 1e-6f;
constexpr int NWAVES = 8, NTHREADS = 512;

constexpr size_t MiB = 1u << 20;
constexpr size_t WS_CTL = 0, CTL_BYTES = 1 * MiB;
constexpr size_t WS_MOD = 1 * MiB;
constexpr size_t WS_ROPE = 2 * MiB;
constexpr size_t WS_W = 4 * MiB, WL_BYTES = 86 * MiB;
constexpr size_t WO_IN = 0, WO_OUT = 14 * MiB, WO_FF1 = 22 * MiB, WO_FF2 = 54 * MiB;
constexpr size_t WS_X = WS_W + 2 * WL_BYTES;
constexpr size_t WS_H = WS_X + 132 * MiB;
constexpr size_t WS_U = WS_H + 66 * MiB;
constexpr size_t WS_P = WS_U;
constexpr size_t WS_CAT = WS_U + 116 * MiB;
constexpr size_t WS_KV = WS_CAT + 66 * MiB;
constexpr size_t WS_QN = WS_KV + 17 * MiB;
constexpr size_t WS_END = WS_U + 264 * MiB;
static_assert(WS_KV + (size_t)MROWS * 512 * 2 <= WS_QN && WS_QN + (size_t)MROWS * 1024 * 2 <= WS_END, "overlay");

constexpr int RING_BYTES = 131072, LDS_BYTES = 147456;

typedef unsigned short bf16raw;
typedef unsigned v4u __attribute__((ext_vector_type(4)));
typedef unsigned v2u __attribute__((ext_vector_type(2)));
typedef float v4f __attribute__((ext_vector_type(4)));
#define LAS __attribute__((address_space(3)))

__device__ __forceinline__ unsigned f2bf(float f) { unsigned u = __builtin_bit_cast(unsigned, f); return (u + 0x7fffu + ((u >> 16) & 1u)) >> 16; }
__device__ __forceinline__ unsigned pk2(float lo, float hi) { return f2bf(lo) | (f2bf(hi) << 16); }
__device__ __forceinline__ float bflo(unsigned w) { return __builtin_bit_cast(float, w << 16); }
__device__ __forceinline__ float bfhi(unsigned w) { return __builtin_bit_cast(float, w & 0xffff0000u); }
__device__ __forceinline__ void unpack8(v4u r, float* x) { x[0] = bflo(r.x); x[1] = bfhi(r.x); x[2] = bflo(r.y); x[3] = bfhi(r.y); x[4] = bflo(r.z); x[5] = bfhi(r.z); x[6] = bflo(r.w); x[7] = bfhi(r.w); }
__device__ __forceinline__ v4u pack8(const float* x) { v4u o; o.x = pk2(x[0], x[1]); o.y = pk2(x[2], x[3]); o.z = pk2(x[4], x[5]); o.w = pk2(x[6], x[7]); return o; }
__device__ __forceinline__ float wave_sum(float v) {
#pragma unroll
    for (int o = 1; o < 64; o <<= 1) v += __shfl_xor(v, o);
    return v;
}

__device__ __forceinline__ int fresh_tid() { int t = threadIdx.x; asm volatile("" : "+v"(t)); return t; }
__device__ __forceinline__ int fresh_bid() { int b = blockIdx.x; asm volatile("" : "+s"(b)); return b; }

namespace pg8 {
#define PG8_LAS __attribute__((address_space(3)))
typedef unsigned short bf16_t;
typedef short bf16x8 __attribute__((ext_vector_type(8)));
typedef float f32x4 __attribute__((ext_vector_type(4)));
typedef unsigned u32x4 __attribute__((ext_vector_type(4)));
constexpr int BM = 256, BK = 64, HALF = 128, HTB = HALF * BK * 2  , STAGE_BYTES = 8 * HTB, NXCD = 8, WGM = 8;

__host__ __device__ __forceinline__ int lds_byte(int r, int c) { const int st = (r >> 4) * 2 + (c >> 5), rr = r & 15, cc = c & 31, ob = rr * 64 + cc * 2; return st * 1024 + (ob ^ (((ob >> 9) & 1) << 5)); }
__host__ __device__ __forceinline__ void stage_rc(int b, int& R, int& C) { const int st = b / 1024, sb = b % 1024, swz = sb ^ (((sb >> 9) & 1) << 5); R = (st >> 1) * 16 + swz / 64; C = (st & 1) * 32 + (swz % 64) / 2; }
__host__ __device__ __forceinline__ int perm32(int rho) { const int n = rho >> 4, i = rho & 15; return 8 * (i >> 2) + 4 * n + (i & 3); }

struct Unit { int pm, pn; };
struct Gemm { const bf16_t* A; const bf16_t* Bt; int M, N, K, ld; };

struct TileOrder {
    int nM, nN, nMain, nwg, G, c, mode;
    __device__ void init(int N, int G_, int c_, int mode_) { mode = mode_; nM = mode_ == 0 ? 66 : 64; nN = N / BM; nMain = nM * nN; nwg = nMain + (mode_ == 2 ? 4 : 0); G = G_; c = c_; }
    __device__ bool next(int i, Unit& u) const {
        const long L = (long)i * G + c; if (L >= nwg) return false;
        int wgid = (int)L; { const int q = nwg / NXCD, r = nwg % NXCD, xcd = wgid % NXCD, off = wgid / NXCD; wgid = (xcd < r ? xcd * (q + 1) : r * (q + 1) + (xcd - r) * q) + off; }
        if (wgid >= nMain) { const int e = wgid - nMain; u.pm = (e >> 1) * 33; u.pn = 4 + (e & 1); return true; }
        const int nig = WGM * nN, gid = wgid / nig, fm = gid * WGM, gsz = (nM - fm) < WGM ? (nM - fm) : WGM;
        const int mt = fm + ((wgid % nig) % gsz); u.pn = (wgid % nig) / gsz;
        u.pm = mode == 0 ? mt : (mt >> 5) * 33 + 1 + (mt & 31); return true;
    }
    __device__ __forceinline__ void a_ready(const Unit&) const {}
    __device__ __forceinline__ void done(const Unit&) const {}
};
struct OneUnit {
    int pm, pn, has;
    __device__ __forceinline__ bool next(int i, Unit& u) const { if (i != 0 || !has) return false; u.pm = pm; u.pn = pn; return true; }
    __device__ __forceinline__ void a_ready(const Unit&) const {}
    __device__ __forceinline__ void done(const Unit&) const {}
};
__device__ __forceinline__ unsigned cvt_pk_bf16(float lo, float hi) { unsigned r; asm volatile("v_cvt_pk_bf16_f32 %0, %1, %2" : "=v"(r) : "v"(lo), "v"(hi)); return r; }
typedef float f32x2 __attribute__((ext_vector_type(2)));
template <int ACT  > struct EpiBf16 {
    static constexpr bool PERM = true, AFTER_DRAIN = false;
    bf16_t* O; int ldc;
    __device__ __forceinline__ void operator()(const f32x4 (&acc)[2][2][4][2], const Unit& u, int wr, int wc, int fr, int fq) const {
        const int row0 = u.pm * BM + wr * 64 + fr; const int col0 = u.pn * BM + wc * 32 + 8 * fq;
#pragma unroll
        for (int ai = 0; ai < 2; ++ai)
#pragma unroll
            for (int m = 0; m < 4; ++m) { bf16_t* rowp = O + (size_t)(row0 + ai * HALF + m * 16) * ldc + col0;
#pragma unroll
                for (int bj = 0; bj < 2; ++bj) { f32x4 v0 = acc[ai][bj][m][0], v1 = acc[ai][bj][m][1];
                    if (ACT == 2) { const f32x4 z = {0.f, 0.f, 0.f, 0.f}; v0 = __builtin_elementwise_max(v0, z); v1 = __builtin_elementwise_max(v1, z); v0 = v0 * v0; v1 = v1 * v1; }
                    u32x4 w; w.x = cvt_pk_bf16(v0[0], v0[1]); w.y = cvt_pk_bf16(v0[2], v0[3]); w.z = cvt_pk_bf16(v1[0], v1[1]); w.w = cvt_pk_bf16(v1[2], v1[3]);
                    *(u32x4*)(rowp + bj * HALF) = w; } }
    }
};
struct EpiGateRes {
    static constexpr bool PERM = true, AFTER_DRAIN = false;
    const float* gate;
    const float* xin; const float* ctxin;
    bf16_t* X; float* out;
    int in_mode, out_mode;
    __device__ __forceinline__ void operator()(const f32x4 (&acc)[2][2][4][2], const Unit& u, int wr, int wc, int fr, int fq) const {
        const int b = u.pm / 33, jt = u.pm % 33, s = jt == 0 ? 2 : b;
        const size_t lat_off = ((size_t)b * 8192 + (size_t)(jt - 1) * 256) * 2048;
        const float* basef = jt == 0 ? ctxin + (size_t)b * 256 * 2048 : xin + lat_off;
        bf16_t* xb = X + (size_t)u.pm * 256 * 2048; float* outf = out + lat_off;
        const int col0 = u.pn * BM + wc * 32 + 8 * fq; const float* gp = gate + (size_t)s * 12288 + col0;
        f32x4 gv[2][2];
#pragma unroll
        for (int bj = 0; bj < 2; ++bj)
#pragma unroll
            for (int n = 0; n < 2; ++n) gv[bj][n] = *(const f32x4*)(gp + bj * HALF + n * 4);
#pragma unroll
        for (int ai = 0; ai < 2; ++ai)
#pragma unroll
            for (int m = 0; m < 4; ++m) { const size_t off = (size_t)(ai * HALF + wr * 64 + m * 16 + fr) * 2048 + col0;
#pragma unroll
                for (int bj = 0; bj < 2; ++bj) { f32x4 b0, b1;
                    if (in_mode) { b0 = *(const f32x4*)(basef + off + bj * HALF); b1 = *(const f32x4*)(basef + off + bj * HALF + 4); }
                    else { const u32x4 w = *(const u32x4*)(xb + off + bj * HALF);
                        b0 = (f32x4){__builtin_bit_cast(float, w.x << 16), __builtin_bit_cast(float, w.x & 0xffff0000u), __builtin_bit_cast(float, w.y << 16), __builtin_bit_cast(float, w.y & 0xffff0000u)};
                        b1 = (f32x4){__builtin_bit_cast(float, w.z << 16), __builtin_bit_cast(float, w.z & 0xffff0000u), __builtin_bit_cast(float, w.w << 16), __builtin_bit_cast(float, w.w & 0xffff0000u)}; }
                    const f32x4 o0 = b0 + gv[bj][0] * acc[ai][bj][m][0], o1 = b1 + gv[bj][1] * acc[ai][bj][m][1];
                    if (out_mode) { *(f32x4*)(outf + off + bj * HALF) = o0; *(f32x4*)(outf + off + bj * HALF + 4) = o1; }
                    else { u32x4 w; w.x = cvt_pk_bf16(o0[0], o0[1]); w.y = cvt_pk_bf16(o0[2], o0[3]); w.z = cvt_pk_bf16(o1[0], o1[1]); w.w = cvt_pk_bf16(o1[2], o1[3]); *(u32x4*)(xb + off + bj * HALF) = w; } }
                if (m & 1) asm volatile("" ::: "memory"); }
    }
};

struct EpiGateAtomic {
    static constexpr bool PERM = false, AFTER_DRAIN = false;
    const float* gate; float* X;
    __device__ __forceinline__ void operator()(const f32x4 (&acc)[2][2][4][2], const Unit& u, int wr, int wc, int fr, int fq) const {
        const int b = u.pm / 33, jt = u.pm % 33, s = jt == 0 ? 2 : b;
        float* outp = X + (size_t)u.pm * 256 * 2048;
        const int col0 = u.pn * BM + wc * 32 + 4 * fq; const float* gp = gate + (size_t)s * 12288 + col0;
        f32x4 gv[2][2];
#pragma unroll
        for (int bj = 0; bj < 2; ++bj)
#pragma unroll
            for (int n = 0; n < 2; ++n) gv[bj][n] = *(const f32x4*)(gp + bj * HALF + n * 16);
#pragma unroll
        for (int ai = 0; ai < 2; ++ai)
#pragma unroll
            for (int m = 0; m < 4; ++m) { const size_t off = (size_t)(ai * HALF + wr * 64 + m * 16 + fr) * 2048 + col0;
#pragma unroll
                for (int bj = 0; bj < 2; ++bj)
#pragma unroll
                    for (int n = 0; n < 2; ++n) { const f32x4 v = gv[bj][n] * acc[ai][bj][m][n]; float* p = outp + off + bj * HALF + n * 16;
#pragma unroll
                        for (int e = 0; e < 4; ++e) (void)__hip_atomic_fetch_add(p + e, v[e], __ATOMIC_RELAXED, __HIP_MEMORY_SCOPE_AGENT); } }
    }
};

struct EpiSlab {
    static constexpr bool PERM = false, AFTER_DRAIN = false;
    float* slab;
    __device__ __forceinline__ void operator()(const f32x4 (&acc)[2][2][4][2], const Unit& u, int wr, int wc, int fr, int fq) const {
        float* outp = slab + (size_t)(u.pm / 33) * 256 * 2048;
        const int col0 = u.pn * BM + wc * 32 + 4 * fq;
#pragma unroll
        for (int ai = 0; ai < 2; ++ai)
#pragma unroll
            for (int m = 0; m < 4; ++m) { const size_t off = (size_t)(ai * HALF + wr * 64 + m * 16 + fr) * 2048 + col0;
#pragma unroll
                for (int bj = 0; bj < 2; ++bj)
#pragma unroll
                    for (int n = 0; n < 2; ++n) *(f32x4*)(outp + off + bj * HALF + n * 16) = acc[ai][bj][m][n]; }
    }
};

template <class Epi, class Sched, bool ALIGN_EPI = false, bool SP2 = false>
__device__ __forceinline__ void gemm_phase(PG8_LAS unsigned char* lds, const Gemm g, const Sched& S, const Epi& E) {
    const int tid = fresh_tid(), wid = __builtin_amdgcn_readfirstlane(tid >> 6), lane = tid & 63, wr = wid >> 2, wc = wid & 3, fr = lane & 15, fq = lane >> 4;
    const int K = g.ld, nt = g.K / BK;
    unsigned voffA[2], voffB[2];
#pragma unroll
    for (int i = 0; i < 2; ++i) { int R, C; stage_rc(tid * 16 + i * 8192, R, C); const int Rb = Epi::PERM ? ((R & ~31) + perm32(R & 31)) : R;
        voffA[i] = (unsigned)(R * K + C) * 2u; voffB[i] = (unsigned)(Rb * K + C) * 2u; }
    const size_t kstep = (size_t)(BK * 2);
    const size_t hstep = (size_t)HALF * K * 2;
    const size_t tstep = 2 * hstep;
    const unsigned ldsw = (unsigned)wid * 1024u;
    const int aoff = lds_byte(wr * 64 + fr, fq * 8), boff = lds_byte(wc * 32 + fr, fq * 8);
#define PG8_SA(b, h) (((b) * 2 + (h)) * HTB)
#define PG8_SB(b, h) ((4 + (b) * 2 + (h)) * HTB)
#define PG8_STAGE(bufoff, gbase, voff) do { _Pragma("unroll") for (int _i = 0; _i < 2; ++_i) \
        __builtin_amdgcn_global_load_lds((const unsigned*)((const char*)(gbase) + (voff)[_i]), (PG8_LAS unsigned*)(lds + (bufoff) + ldsw + _i * 8192), 16, 0, 0); } while (0)
#define PG8_LDA(dst, b, h) do { _Pragma("unroll") for (int m = 0; m < 4; ++m) _Pragma("unroll") for (int k = 0; k < 2; ++k) dst[m][k] = *(const PG8_LAS bf16x8*)(lds + PG8_SA(b, h) + aoff + m * 2048 + k * 1024); } while (0)
#define PG8_LDB(dst, b, h) do { _Pragma("unroll") for (int n = 0; n < 2; ++n) _Pragma("unroll") for (int k = 0; k < 2; ++k) dst[n][k] = *(const PG8_LAS bf16x8*)(lds + PG8_SB(b, h) + boff + n * 2048 + k * 1024); } while (0)
#define PG8_MMA(ai, bj, At, Bt) do { __builtin_amdgcn_s_setprio(1); _Pragma("unroll") for (int m = 0; m < 4; ++m) _Pragma("unroll") for (int n = 0; n < 2; ++n) _Pragma("unroll") for (int k = 0; k < 2; ++k) \
        acc[ai][bj][m][n] = __builtin_amdgcn_mfma_f32_16x16x32_bf16(Bt[n][k], At[m][k], acc[ai][bj][m][n], 0, 0, 0); __builtin_amdgcn_s_setprio(0); } while (0)
#define PG8_WAIT_V(n) asm volatile("s_waitcnt vmcnt(" #n ")" ::: "memory")
#define PG8_WAIT_L(n) asm volatile("s_waitcnt lgkmcnt(" #n ")" ::: "memory")
#define PG8_BAR __builtin_amdgcn_s_barrier()
#define PG8_SCHED __builtin_amdgcn_sched_barrier(0)
    Unit cur, nxt; int ui = 0;
    if (!S.next(0, cur)) return;
    f32x4 acc[2][2][4][2];
#pragma unroll
    for (int a = 0; a < 2; ++a)
#pragma unroll
        for (int b = 0; b < 2; ++b)
#pragma unroll
            for (int m = 0; m < 4; ++m)
#pragma unroll
                for (int n = 0; n < 2; ++n) acc[a][b][m][n] = (f32x4){0.f, 0.f, 0.f, 0.f};
    bf16x8 At[4][2], B0[2][2], B1[2][2];
    const char* cA = (const char*)g.A + (size_t)cur.pm * tstep; const char* cB = (const char*)g.Bt + (size_t)cur.pn * tstep;
    S.a_ready(cur);
    if constexpr (SP2) {
        PG8_STAGE(PG8_SB(0, 0), cB, voffB); PG8_STAGE(PG8_SB(0, 1), cB + hstep, voffB); PG8_STAGE(PG8_SA(0, 0), cA, voffA); PG8_STAGE(PG8_SA(0, 1), cA + hstep, voffA);
        if (wr == 1) PG8_BAR;
        PG8_WAIT_V(2); PG8_BAR;
        PG8_STAGE(PG8_SB(1, 0), cB + kstep, voffB); PG8_STAGE(PG8_SA(1, 0), cA + kstep, voffA); PG8_STAGE(PG8_SB(1, 1), cB + hstep + kstep, voffB);
        PG8_WAIT_V(6); PG8_BAR;
    } else {
        PG8_STAGE(PG8_SB(0, 0), cB, voffB); PG8_STAGE(PG8_SA(0, 0), cA, voffA); PG8_STAGE(PG8_SB(0, 1), cB + hstep, voffB); PG8_STAGE(PG8_SA(0, 1), cA + hstep, voffA);
        if (wr == 1) PG8_BAR;
        PG8_WAIT_V(4); PG8_BAR;
        PG8_STAGE(PG8_SB(1, 0), cB + kstep, voffB); PG8_STAGE(PG8_SA(1, 0), cA + kstep, voffA); PG8_STAGE(PG8_SB(1, 1), cB + hstep + kstep, voffB);
        PG8_WAIT_V(6); PG8_BAR;
    }
    for (;;) {
        const bool has_next = S.next(ui + 1, nxt);
        const char* nA = has_next ? (const char*)g.A + (size_t)nxt.pm * tstep : cA; const char* nB = has_next ? (const char*)g.Bt + (size_t)nxt.pn * tstep : cB;
        for (int t = 0; t < nt; t += 2) {
            const bool last = (t == nt - 2);
            const char* a1 = cA + (size_t)(t + 1) * kstep;
            const char* a2 = last ? nA : cA + (size_t)(t + 2) * kstep; const char* b2 = last ? nB : cB + (size_t)(t + 2) * kstep;
            const char* a3 = a2 + kstep; const char* b3 = b2 + kstep;
            if (last && has_next) S.a_ready(nxt);
            if constexpr (SP2) {
            PG8_LDB(B0, 0, 0); PG8_LDB(B1, 0, 1); PG8_SCHED; PG8_LDA(At, 0, 0); PG8_STAGE(PG8_SA(1, 1), a1 + hstep, voffA);
            PG8_WAIT_V(8); PG8_WAIT_L(0); PG8_BAR; PG8_MMA(0, 0, At, B0); PG8_MMA(0, 1, At, B1); PG8_BAR; PG8_SCHED;
            PG8_LDA(At, 0, 1); PG8_STAGE(PG8_SB(0, 0), b2, voffB); PG8_STAGE(PG8_SB(0, 1), b2 + hstep, voffB); PG8_STAGE(PG8_SA(0, 0), a2, voffA);
            PG8_WAIT_V(8); PG8_WAIT_L(0); PG8_BAR; PG8_MMA(1, 0, At, B0); PG8_MMA(1, 1, At, B1); PG8_BAR; PG8_SCHED;
            PG8_LDB(B0, 1, 0); PG8_LDB(B1, 1, 1); PG8_SCHED; PG8_LDA(At, 1, 0); PG8_STAGE(PG8_SA(0, 1), a2 + hstep, voffA);
            PG8_WAIT_V(8); PG8_WAIT_L(0); PG8_BAR; PG8_MMA(0, 0, At, B0); PG8_MMA(0, 1, At, B1); PG8_BAR; PG8_SCHED;
            PG8_LDA(At, 1, 1); PG8_STAGE(PG8_SB(1, 0), b3, voffB); PG8_STAGE(PG8_SB(1, 1), b3 + hstep, voffB); PG8_STAGE(PG8_SA(1, 0), a3, voffA);
            PG8_WAIT_V(8); PG8_WAIT_L(0); PG8_BAR; PG8_MMA(1, 0, At, B0); PG8_MMA(1, 1, At, B1); PG8_BAR; PG8_SCHED;
            } else {
            PG8_LDB(B0, 0, 0); PG8_SCHED; PG8_LDA(At, 0, 0); PG8_STAGE(PG8_SA(1, 1), a1 + hstep, voffA);
            PG8_WAIT_L(8); PG8_BAR; PG8_WAIT_L(0); PG8_MMA(0, 0, At, B0); PG8_BAR; PG8_SCHED;
            PG8_LDB(B1, 0, 1); PG8_STAGE(PG8_SB(0, 0), b2, voffB);
            PG8_BAR; PG8_WAIT_L(0); PG8_MMA(0, 1, At, B1); PG8_BAR;
            PG8_LDA(At, 0, 1); PG8_STAGE(PG8_SA(0, 0), a2, voffA);
            PG8_BAR; PG8_WAIT_L(0); PG8_MMA(1, 0, At, B0); PG8_BAR; PG8_SCHED;
            PG8_STAGE(PG8_SB(0, 1), b2 + hstep, voffB);
            PG8_WAIT_V(6); PG8_BAR; PG8_MMA(1, 1, At, B1); PG8_BAR;
            PG8_LDB(B0, 1, 0); PG8_SCHED; PG8_LDA(At, 1, 0); PG8_STAGE(PG8_SA(0, 1), a2 + hstep, voffA);
            PG8_WAIT_L(8); PG8_BAR; PG8_WAIT_L(0); PG8_MMA(0, 0, At, B0); PG8_BAR; PG8_SCHED;
            PG8_LDB(B1, 1, 1); PG8_STAGE(PG8_SB(1, 0), b3, voffB);
            PG8_BAR; PG8_WAIT_L(0); PG8_MMA(0, 1, At, B1); PG8_BAR;
            PG8_LDA(At, 1, 1); PG8_STAGE(PG8_SA(1, 0), a3, voffA);
            PG8_BAR; PG8_WAIT_L(0); PG8_MMA(1, 0, At, B0); PG8_BAR; PG8_SCHED;
            PG8_STAGE(PG8_SB(1, 1), b3 + hstep, voffB);
            PG8_WAIT_V(6); PG8_BAR; PG8_MMA(1, 1, At, B1); PG8_BAR;
            }
        }
        if constexpr (ALIGN_EPI) { if (wr == 0) PG8_BAR; }
        if constexpr (!Epi::AFTER_DRAIN) { E(acc, cur, wr, wc, fr, fq); S.done(cur); }
        if (!has_next) break;
#pragma unroll
        for (int a = 0; a < 2; ++a)
#pragma unroll
            for (int b = 0; b < 2; ++b)
#pragma unroll
                for (int m = 0; m < 4; ++m)
#pragma unroll
                    for (int n = 0; n < 2; ++n) acc[a][b][m][n] = (f32x4){0.f, 0.f, 0.f, 0.f};
        cur = nxt; cA = nA; cB = nB; ++ui;
        if constexpr (ALIGN_EPI) { if (wr == 1) PG8_BAR; }
    }
    PG8_WAIT_V(0);
    if constexpr (!ALIGN_EPI) { if (wr == 0) PG8_BAR; }
    PG8_BAR;
    if constexpr (Epi::AFTER_DRAIN) { E.fused(acc, cur, wr, wc, fr, fq, lds, wid, lane); S.done(cur); }
#undef PG8_SA
#undef PG8_SB
#undef PG8_STAGE
#undef PG8_LDA
#undef PG8_LDB
#undef PG8_MMA
#undef PG8_WAIT_V
#undef PG8_WAIT_L
#undef PG8_BAR
#undef PG8_SCHED
}
}
namespace att {
using bf16 = __hip_bfloat16;
constexpr int   D = 128, NW = 8, QBLK = 32, KVBLK = 64;
constexpr float SCALE = 0.088388347648318440f;
constexpr float THR = 8.f;
constexpr int SDEPTH = 1;
constexpr size_t SHM_V = KVBLK * D * 2, SHM_K = KVBLK * D * 2, SHM_ATTN = 3 * SHM_V + 3 * SHM_K + NW * 64 * 4;
using bf16x8 = __attribute__((ext_vector_type(8))) short;
using s16x4  = __attribute__((ext_vector_type(4))) short;
using f32x16 = __attribute__((ext_vector_type(16))) float;
using f32x8  = __attribute__((ext_vector_type(8))) float;
using u32x4  = __attribute__((ext_vector_type(4))) unsigned;
#define KSWZ(row, colB) ((row) * 256 + ((colB) ^ (((row) & 7) << 4)))
#define SBAR() __builtin_amdgcn_sched_barrier(0)
__device__ __forceinline__ int crow(int r, int hi) { return (r & 3) + 8 * (r >> 2) + 4 * hi; }
__device__ __forceinline__ unsigned cvtpk(float lo, float hi) {
  unsigned r; asm volatile("v_cvt_pk_bf16_f32 %0, %1, %2" : "=v"(r) : "v"(lo), "v"(hi)); return r;
}
template <typename TIn> struct Stage;
template <> struct Stage<bf16>  { using T = bf16x8;
  __device__ static __forceinline__ T ld8(const bf16* p) { return *reinterpret_cast<const bf16x8*>(p); }
  __device__ static __forceinline__ bf16x8 tobf(T x) { return x; } };
template <> struct Stage<float> { using T = f32x8;
  __device__ static __forceinline__ T ld8(const float* p) { return *reinterpret_cast<const f32x8*>(p); }
  __device__ static __forceinline__ bf16x8 tobf(T x) {
    u32x4 w = {cvtpk(x[0], x[1]), cvtpk(x[2], x[3]), cvtpk(x[4], x[5]), cvtpk(x[6], x[7])}; return *reinterpret_cast<bf16x8*>(&w); } };

__device__ __forceinline__ void partialSM(f32x16& p0, f32x16& p1, float& m_reg, f32x16& negm, float& alpha) {
  constexpr float THRL = THR * 1.4426950408889634f;
  float pmax = p0[0]; for (int r = 1; r < 16; ++r) pmax = fmaxf(pmax, p0[r]); for (int r = 0; r < 16; ++r) pmax = fmaxf(pmax, p1[r]);
  { auto rr = __builtin_amdgcn_permlane32_swap(__float_as_uint(pmax), __float_as_uint(pmax), false, false);
    pmax = fmaxf(__uint_as_float(rr[0]), __uint_as_float(rr[1])); }
  if (__builtin_expect(__all(pmax <= THRL), 1)) { alpha = 1.f; }
  else { const float dl = fmaxf(pmax, 0.f); m_reg += dl; alpha = __builtin_amdgcn_exp2f(-dl);
    for (int r = 0; r < 16; ++r) { p0[r] -= dl; p1[r] -= dl; }
    const float nm = -m_reg; for (int r = 0; r < 16; ++r) negm[r] = nm; }
  for (int r = 0; r < 16; ++r) p0[r] = __builtin_amdgcn_exp2f(p0[r]);
}
__device__ __forceinline__ void finishSM(f32x16& p0, f32x16& p1, float alpha, float& l_reg, bf16x8& pa0, bf16x8& pa1, bf16x8& pa2, bf16x8& pa3) {
  for (int r = 0; r < 16; ++r) p1[r] = __builtin_amdgcn_exp2f(p1[r]);
  float ps = 0; for (int r = 0; r < 16; ++r) ps += p0[r]; for (int r = 0; r < 16; ++r) ps += p1[r];
  { auto rr = __builtin_amdgcn_permlane32_swap(__float_as_uint(ps), __float_as_uint(ps), false, false);
    ps = __uint_as_float(rr[0]) + __uint_as_float(rr[1]); }
  l_reg = l_reg * alpha + ps;
#define PK4(P, BASE, OUT) do { unsigned a0 = cvtpk(P[BASE + 0], P[BASE + 1]), a1 = cvtpk(P[BASE + 2], P[BASE + 3]);   \
    unsigned b0 = cvtpk(P[BASE + 4], P[BASE + 5]), b1 = cvtpk(P[BASE + 6], P[BASE + 7]);                              \
    auto r0 = __builtin_amdgcn_permlane32_swap(a0, b0, false, false); auto r1 = __builtin_amdgcn_permlane32_swap(a1, b1, false, false); \
    u32x4 w = {r0[0], r1[0], r0[1], r1[1]}; OUT = *reinterpret_cast<bf16x8*>(&w); } while (0)
  PK4(p0, 0, pa0); PK4(p0, 8, pa1); PK4(p1, 0, pa2); PK4(p1, 8, pa3);
#undef PK4
}
__device__ __forceinline__ void qkt(f32x16& p0, f32x16& p1, const bf16* Ks, const bf16x8* qr, const f32x16& negm, int r32, int hi) {
#pragma unroll
  for (int d0 = 0; d0 < 8; ++d0) { int cb = (d0 * 16 + hi * 8) * 2;
    bf16x8 b0 = *reinterpret_cast<const bf16x8*>((const char*)Ks + KSWZ(r32, cb));
    bf16x8 b1 = *reinterpret_cast<const bf16x8*>((const char*)Ks + KSWZ(32 + r32, cb));
    if (d0 == 0) { p0 = __builtin_amdgcn_mfma_f32_32x32x16_bf16(b0, qr[0], negm, 0, 0, 0); p1 = __builtin_amdgcn_mfma_f32_32x32x16_bf16(b1, qr[0], negm, 0, 0, 0); }
    else { p0 = __builtin_amdgcn_mfma_f32_32x32x16_bf16(b0, qr[d0], p0, 0, 0, 0); p1 = __builtin_amdgcn_mfma_f32_32x32x16_bf16(b1, qr[d0], p1, 0, 0, 0); } }
}
__device__ __forceinline__ int v_st(int k, int c) { const int kk = (k & ~0xC) | ((k & 4) << 1) | ((k & 8) >> 1); return ((kk >> 3) * 4 + (c >> 5)) * 512 + ((kk & 7) * 32 + (c & 31)) * 2; }
__device__ __forceinline__ int v_rd_base(int lane) { return ((lane & 3) << 3) | (((lane >> 2) & 3) << 6) | (((lane >> 4) & 1) << 5) | (((lane >> 5) & 1) << 8); }
constexpr int v_rd_off(int d0, int ks, int half) { return d0 * 512 + ks * 4096 + half * 2048; }
template <int OFF> __device__ __forceinline__ s16x4 tr_read(int vb) {
  s16x4 r; asm volatile("ds_read_b64_tr_b16 %0, %1 offset:%2" : "=&v"(r) : "v"(vb), "i"(OFF) : "memory"); return r;
}
template <int D0> __device__ __forceinline__ void pv_one(f32x16& od, int vb, bf16x8 pa0, bf16x8 pa1, bf16x8 pa2, bf16x8 pa3) {
  const s16x4 l0 = tr_read<v_rd_off(D0, 0, 0)>(vb), h0 = tr_read<v_rd_off(D0, 0, 1)>(vb), l1 = tr_read<v_rd_off(D0, 1, 0)>(vb), h1 = tr_read<v_rd_off(D0, 1, 1)>(vb);
  const s16x4 l2 = tr_read<v_rd_off(D0, 2, 0)>(vb), h2 = tr_read<v_rd_off(D0, 2, 1)>(vb), l3 = tr_read<v_rd_off(D0, 3, 0)>(vb), h3 = tr_read<v_rd_off(D0, 3, 1)>(vb);
  asm volatile("s_waitcnt lgkmcnt(0)" ::: "memory"); SBAR();
#define PK(L, H) (bf16x8){L[0], L[1], L[2], L[3], H[0], H[1], H[2], H[3]}
  od = __builtin_amdgcn_mfma_f32_32x32x16_bf16(pa0, PK(l0, h0), od, 0, 0, 0);
  od = __builtin_amdgcn_mfma_f32_32x32x16_bf16(pa1, PK(l1, h1), od, 0, 0, 0);
  od = __builtin_amdgcn_mfma_f32_32x32x16_bf16(pa2, PK(l2, h2), od, 0, 0, 0);
  od = __builtin_amdgcn_mfma_f32_32x32x16_bf16(pa3, PK(l3, h3), od, 0, 0, 0);
#undef PK
}
__device__ __forceinline__ void pv_d0(f32x16* o, int vb, bf16x8 pa0, bf16x8 pa1, bf16x8 pa2, bf16x8 pa3) {
  pv_one<0>(o[0], vb, pa0, pa1, pa2, pa3); pv_one<1>(o[1], vb, pa0, pa1, pa2, pa3); pv_one<2>(o[2], vb, pa0, pa1, pa2, pa3); pv_one<3>(o[3], vb, pa0, pa1, pa2, pa3);
}
template <int LDQ, int LDK, int LDO>
__device__ __forceinline__ void attn_dense_body(const bf16* __restrict__ Qb, const bf16* __restrict__ Kh, const bf16* __restrict__ Vh,
                                                bf16* __restrict__ Ob, int seq, char* lds) {
  using TQ = bf16;
  using St = Stage<bf16>; using SQ = Stage<TQ>;
  const int tid = fresh_tid(), wid = tid >> 6, lane = tid & 63, r32 = lane & 31, hi = lane >> 5;
  bf16* V_lds = (bf16*)lds; bf16* K_lds = (bf16*)(lds + 3 * SHM_V);
  float* ws = (float*)(lds + 3 * SHM_V + 3 * SHM_K) + wid * 64; float* li_l = ws; float* al_l = ws + 32;
  float m_reg = 0.f, l_reg = 0; f32x16 o[4] = {}; bf16x8 qr[8]; f32x16 negm = {}; asm volatile("" : "+v"(negm));
  const TQ* Qw = Qb + (long)(wid * QBLK + r32) * LDQ + hi * 8;
#pragma unroll
  for (int d0 = 0; d0 < 8; ++d0) qr[d0] = SQ::tobf(SQ::ld8(Qw + d0 * 16));
  const int sr = tid >> 4, sc = (tid & 15) * 8, vst0 = v_st(sr, sc), vst1 = v_st(32 + sr, sc);
  const int vb0 = (int)(uintptr_t)V_lds + v_rd_base(lane);
  struct { typename St::T vs0, vs1, ks0, ks1; } sr_[SDEPTH];
#define SLOAD(i, k0) do { sr_[i].vs0 = St::ld8(&Vh[(long)((k0) + sr) * LDK + sc]); sr_[i].vs1 = St::ld8(&Vh[(long)((k0) + 32 + sr) * LDK + sc]); \
    sr_[i].ks0 = St::ld8(&Kh[(long)((k0) + sr) * LDK + sc]); sr_[i].ks1 = St::ld8(&Kh[(long)((k0) + 32 + sr) * LDK + sc]); } while (0)
#define SWRITE(off, i) do { *(bf16x8*)((char*)V_lds + (off) + vst0) = St::tobf(sr_[i].vs0);          \
    *(bf16x8*)((char*)V_lds + (off) + vst1) = St::tobf(sr_[i].vs1); int kc = sc * 2;               \
    *(bf16x8*)((char*)K_lds + (off) + KSWZ(sr, kc)) = St::tobf(sr_[i].ks0);                       \
    *(bf16x8*)((char*)K_lds + (off) + KSWZ(32 + sr, kc)) = St::tobf(sr_[i].ks1); } while (0)
#define SWAIT() do { if constexpr (SDEPTH == 2) asm volatile("s_waitcnt vmcnt(4)" ::: "memory"); else asm volatile("s_waitcnt vmcnt(0)" ::: "memory"); } while (0)
#define RESC(a) do { if (__any((a) < 1.f)) { if (hi == 0) al_l[r32] = (a); asm volatile("s_waitcnt lgkmcnt(0)" ::: "memory"); \
    for (int d = 0; d < 4; ++d) for (int r = 0; r < 16; ++r) o[d][r] *= al_l[crow(r, hi)]; } } while (0)
  f32x16 pA0, pA1, pB0, pB1; float alA, alB; bf16x8 pa0, pa1, pa2, pa3; const int NT = seq / KVBLK;
  constexpr int SE = 0, SO = SDEPTH - 1;
  SLOAD(SE, 0); asm volatile("s_waitcnt vmcnt(0)" ::: "memory"); SWRITE(0, SE); __syncthreads();
  qkt(pA0, pA1, K_lds, qr, negm, r32, hi); partialSM(pA0, pA1, m_reg, negm, alA);
  SLOAD(SO, KVBLK); if constexpr (SDEPTH == 2) { if (2 < NT) SLOAD(SE, 2 * KVBLK); }
  SWAIT(); SWRITE((int)SHM_V, SO); __syncthreads();
  int o_prv = 0, o_cur = (int)SHM_V, o_nxt = 2 * (int)SHM_V;
  if (wid >= 4) __builtin_amdgcn_s_setprio(1);
#define ROT3() do { const int t_ = o_prv; o_prv = o_cur; o_cur = o_nxt; o_nxt = t_; } while (0)
  for (int j = 1; j + 1 < NT; j += 2) {
    SBAR(); SLOAD(SO, (j + SDEPTH) * KVBLK); SBAR();
    qkt(pB0, pB1, (bf16*)((char*)K_lds + o_cur), qr, negm, r32, hi);
    finishSM(pA0, pA1, alA, l_reg, pa0, pa1, pa2, pa3); SBAR();
    pv_d0(o, vb0 + o_prv, pa0, pa1, pa2, pa3); partialSM(pB0, pB1, m_reg, negm, alB);
    SWAIT(); SWRITE(o_nxt, SE);
    RESC(alB); __syncthreads(); ROT3();
    SBAR(); if (SDEPTH == 1 || j + 3 < NT) SLOAD(SE, (j + 1 + SDEPTH) * KVBLK); SBAR();
    qkt(pA0, pA1, (bf16*)((char*)K_lds + o_cur), qr, negm, r32, hi);
    finishSM(pB0, pB1, alB, l_reg, pa0, pa1, pa2, pa3); SBAR();
    pv_d0(o, vb0 + o_prv, pa0, pa1, pa2, pa3); partialSM(pA0, pA1, m_reg, negm, alA);
    SWAIT(); SWRITE(o_nxt, SO);
    RESC(alA); __syncthreads(); ROT3();
  }
  SBAR(); qkt(pB0, pB1, (bf16*)((char*)K_lds + o_cur), qr, negm, r32, hi);
  finishSM(pA0, pA1, alA, l_reg, pa0, pa1, pa2, pa3); SBAR();
  pv_d0(o, vb0 + o_prv, pa0, pa1, pa2, pa3); partialSM(pB0, pB1, m_reg, negm, alB);
  RESC(alB);
  finishSM(pB0, pB1, alB, l_reg, pa0, pa1, pa2, pa3); SBAR();
  pv_d0(o, vb0 + o_cur, pa0, pa1, pa2, pa3);
  __builtin_amdgcn_s_setprio(0);
#undef ROT3
  if (hi == 0) li_l[r32] = l_reg; asm volatile("s_waitcnt lgkmcnt(0)" ::: "memory");
  float rli[16];
#pragma unroll
  for (int r = 0; r < 16; ++r) rli[r] = __builtin_amdgcn_rcpf(li_l[crow(r, hi)]);
  bf16* Ow = Ob + (long)(wid * QBLK) * LDO;
#pragma unroll
  for (int r = 0; r < 16; ++r) { int orow = crow(r, hi);
    for (int d0 = 0; d0 < 4; ++d0) Ow[(long)orow * LDO + d0 * 32 + r32] = __float2bfloat16(o[d0][r] * rli[r]); }
#undef SLOAD
#undef SWRITE
#undef SWAIT
#undef RESC
  __syncthreads();
}
#undef KSWZ
#undef SBAR
}
struct Args { const float* in[17]; float* out; unsigned char* ws; };

typedef const __attribute__((address_space(4))) Args* KArgs;
__device__ __forceinline__ KArgs kargs() { KArgs p = (KArgs)__builtin_amdgcn_kernarg_segment_ptr(); asm volatile("" : "+s"(p)); return p; }
struct Frame {
    LAS unsigned char* lds;
    int tid, lane, wave, vcu, G, gw, NGW;
    __device__ __forceinline__ void init(unsigned char* lds_) {
        lds = (LAS unsigned char*)lds_;
        tid = fresh_tid(); lane = tid & 63; wave = __builtin_amdgcn_readfirstlane(tid >> 6);
        G = gridDim.x; { const int bx = fresh_bid(); vcu = (G % 8 == 0) ? (bx % 8) * (G / 8) + bx / 8 : bx; }
        gw = vcu * NWAVES + wave; NGW = G * NWAVES;
    }
};
#define FIN(i) (ka->in[i])
#define FWS (ka->ws)

#define XB_TMO      128
#define XB_XCNT(j)  (256  + 64 * (j))
#define XB_XSUB(j)  (1280 + 64 * (j))
#define XB_XGEN(j)  (2304 + 64 * (j))
#define XB_TOP      3328
#define XB_TOPGEN   3392
#define XCD_BAR_WORDS 3456
#define XB_SPIN_CAP (1u << 18)

__device__ __forceinline__ unsigned xb_ld(unsigned* p)              { return __hip_atomic_load(p, __ATOMIC_RELAXED, __HIP_MEMORY_SCOPE_AGENT); }
__device__ __forceinline__ unsigned xb_add(unsigned* p, unsigned v) { return __hip_atomic_fetch_add(p, v, __ATOMIC_RELAXED, __HIP_MEMORY_SCOPE_AGENT); }
__device__ __forceinline__ unsigned xb_xcc_id() { return (unsigned)__builtin_amdgcn_s_getreg((3 << 11) | 20) & 0xFu; }
#define XB_SPIN(cond, bar) do { unsigned _sp = 0; while (cond) { __builtin_amdgcn_s_sleep(1); \
    if ((++_sp & 255u) == 0u) { if (xb_ld(&(bar)[XB_TMO])) break; if (_sp > XB_SPIN_CAP) { atomicAdd(&(bar)[XB_TMO], 1u); break; } } } } while (0)

struct XcdBarrier {
    unsigned* bar; unsigned x;
    volatile LAS unsigned* st;
};

__device__ __forceinline__ XcdBarrier xcd_barrier_post(unsigned* bar, volatile LAS unsigned* st) {
    XcdBarrier b; b.bar = bar; b.x = xb_xcc_id(); b.st = st;
    if (threadIdx.x == 0) (void)xb_add(&bar[XB_XCNT(b.x)], 1u);
    return b;
}
__device__ __forceinline__ void xcd_barrier_complete(unsigned* bar, unsigned x, unsigned& nloc, unsigned& nx) {
    const unsigned G = gridDim.x * gridDim.y * gridDim.z;
    unsigned sum, cnt, mine, sp = 0u;
    for (;;) {
        sum = 0u; cnt = 0u; mine = 0u;
#pragma unroll
        for (unsigned j = 0; j < 16; ++j) { const unsigned c = xb_ld(&bar[XB_XCNT(j)]); sum += c; cnt += (c > 0u) ? 1u : 0u; mine = (j == x) ? c : mine; }
        if (sum == G) break;
        __builtin_amdgcn_s_sleep(1);
        if ((++sp & 255u) == 0u) { if (xb_ld(&bar[XB_TMO])) break; if (sp > XB_SPIN_CAP) { atomicAdd(&bar[XB_TMO], 1u); break; } }
    }
    nloc = mine > 0u ? mine : 1u; nx = cnt > 0u ? cnt : 1u;
}

__device__ __forceinline__ void xcd_barrier(const XcdBarrier& b) {
    asm volatile("s_waitcnt vmcnt(0)" ::: "memory");
    __syncthreads();
    if (threadIdx.x == 0) {
        unsigned* bar = b.bar;
        __builtin_amdgcn_s_waitcnt(0);
        unsigned nloc = b.st[0], nx = b.st[1];
        if (nloc == 0u) { xcd_barrier_complete(bar, b.x, nloc, nx); b.st[0] = nloc; b.st[1] = nx; }
        const unsigned old = xb_add(&bar[XB_XSUB(b.x)], 1u);
        const unsigned gen = old / nloc;
        if (old + 1u == (gen + 1u) * nloc) {
            __builtin_amdgcn_fence(__ATOMIC_RELEASE, "agent");
            asm volatile("s_waitcnt vmcnt(0)" ::: "memory");
            const unsigned og = xb_add(&bar[XB_TOP], 1u);
            const unsigned tg = og / nx;
            if (og + 1u == (tg + 1u) * nx) xb_add(&bar[XB_TOPGEN], 1u);
            else XB_SPIN(xb_ld(&bar[XB_TOPGEN]) == tg, bar);
            __builtin_amdgcn_fence(__ATOMIC_ACQUIRE, "agent");
            xb_add(&bar[XB_XGEN(b.x)], 1u);
            asm volatile("s_waitcnt vmcnt(0)" ::: "memory");
        } else {
            XB_SPIN(xb_ld(&bar[XB_XGEN(b.x)]) == gen, bar);
            __builtin_amdgcn_fence(__ATOMIC_ACQUIRE, "agent");
            asm volatile("s_waitcnt vmcnt(0)" ::: "memory");
        }
    }
    __syncthreads();
}

constexpr int XB_LDS_OFF = RING_BYTES + 64;
constexpr int XB_WORD0 = 1024;
__device__ __forceinline__ void grid_bar(unsigned char* lds_) {
    KArgs ka = kargs();
    XcdBarrier b; b.bar = (unsigned*)(ka->ws + WS_CTL) + XB_WORD0; b.x = xb_xcc_id(); b.st = (volatile LAS unsigned*)((LAS unsigned char*)lds_ + XB_LDS_OFF);
    xcd_barrier(b);
}

__device__ __forceinline__ void p0_transpose_item(const float* W, int K, int N, bf16raw* WT, LAS float* scr, int kb, int nb, int lane) {
    const int k0 = 64 * kb, n0 = 32 * nb;
#pragma unroll 8
    for (int i = 0; i < 32; ++i) { const int kk = 2 * i + (lane >> 5); scr[kk * 33 + (lane & 31)] = W[(size_t)(k0 + kk) * N + n0 + (lane & 31)]; }
    asm volatile("s_waitcnt lgkmcnt(0)" ::: "memory");
    const int c = lane & 7;
#pragma unroll
    for (int j = 0; j < 4; ++j) { const int n = (lane >> 3) + 8 * j; const LAS float* s = scr + (8 * c) * 33 + n;
        v4u o; o.x = pk2(s[0 * 33], s[1 * 33]); o.y = pk2(s[2 * 33], s[3 * 33]); o.z = pk2(s[4 * 33], s[5 * 33]); o.w = pk2(s[6 * 33], s[7 * 33]);
        *(v4u*)(WT + (size_t)(n0 + n) * K + k0 + 8 * c) = o; }
    asm volatile("s_waitcnt lgkmcnt(0)" ::: "memory");
}
__device__ __forceinline__ void p0_fold_item(const float* wpool, const float* ps, const float* wout, bf16raw* WT, int it, int lane) {
    const int nb = it & 63, ct = it >> 6, g = ct >> 3, c0 = (ct & 7) * 16, n = nb * 32 + (lane & 31), ch = lane >> 5;
    const float* wp = wpool + ((size_t)g * 128 + c0 + ch * 8) * 128;
    const float* wo = wout + (size_t)(1024 + g * 128) * 2048 + n;
    const float* psg = ps + g * 128;
    float acc[8];
#pragma unroll
    for (int i = 0; i < 8; ++i) acc[i] = 0.f;
#pragma unroll 2
    for (int e4 = 0; e4 < 32; ++e4) {
        const v4f pv = *(const v4f*)(psg + 4 * e4);
        const float w0 = wo[(size_t)(4 * e4 + 0) * 2048] * pv.x, w1 = wo[(size_t)(4 * e4 + 1) * 2048] * pv.y, w2 = wo[(size_t)(4 * e4 + 2) * 2048] * pv.z, w3 = wo[(size_t)(4 * e4 + 3) * 2048] * pv.w;
#pragma unroll
        for (int i = 0; i < 8; ++i) { const v4f p = *(const v4f*)(wp + i * 128 + 4 * e4); acc[i] += p.x * w0 + p.y * w1 + p.z * w2 + p.w * w3; }
    }
    *(v4u*)(WT + (size_t)n * 2048 + 1024 + g * 128 + c0 + ch * 8) = pack8(acc);
}

__device__ __forceinline__ void p0_prologue(unsigned char* lds_) {
    KArgs ka = kargs(); Frame F; F.init(lds_);
    LAS float* ACT = (LAS float*)F.lds;
    LAS float* PART = (LAS float*)(F.lds + 32768);
    for (int idx = F.tid; idx < 3 * 2048; idx += NTHREADS) { const int s = idx >> 11, d = idx & 2047; const float v = s < 2 ? FIN(1)[s * 2048 + d] : FIN(3)[d]; ACT[idx] = v / (1.f + expf(-v)); }
    __syncthreads();
    float* mod = (float*)(FWS + WS_MOD);
    for (int item = blockIdx.x; item < 256; item += F.G) {
        const int col0 = item * 96, l = col0 / 12288, cl = col0 % 12288;
        if (F.tid < 504) {
            const int cq = F.tid % 24, rg = F.tid / 24; const float* wp = FIN(4) + (size_t)l * 2048 * 12288 + cl + cq * 4;
            v4f a0 = {0.f, 0.f, 0.f, 0.f}, a1 = a0, a2 = a0;
#pragma unroll 7
            for (int d = rg; d < 2048; d += 21) { const v4f w = *(const v4f*)(wp + (size_t)d * 12288); a0 += w * ACT[d]; a1 += w * ACT[2048 + d]; a2 += w * ACT[4096 + d]; }
            *(LAS v4f*)(PART + (rg * 3 + 0) * 96 + cq * 4) = a0; *(LAS v4f*)(PART + (rg * 3 + 1) * 96 + cq * 4) = a1; *(LAS v4f*)(PART + (rg * 3 + 2) * 96 + cq * 4) = a2;
        }
        __syncthreads();
        if (F.tid < 288) { const int s = F.tid / 96, cc = F.tid % 96; float sum = FIN(5)[l * 12288 + cl + cc];
            for (int rg = 0; rg < 21; ++rg) sum += PART[(rg * 3 + s) * 96 + cc];
            mod[(size_t)(l * 3 + s) * 12288 + cl + cc] = sum; }
        __syncthreads();
    }
    { bf16raw* Xb = (bf16raw*)(FWS + WS_X); const int gt = F.vcu * NTHREADS + F.tid, NT_ = F.G * NTHREADS;
      for (int i = gt; i < NB * CTX * 256; i += NT_) { const int row = i >> 8, c8 = i & 255, b = row >> 8, j = row & 255;
          const v4f a0 = *(const v4f*)(FIN(2) + (size_t)row * 2048 + c8 * 8), a1 = *(const v4f*)(FIN(2) + (size_t)row * 2048 + c8 * 8 + 4);
          v4u w; w.x = pk2(a0.x, a0.y); w.y = pk2(a0.z, a0.w); w.z = pk2(a1.x, a1.y); w.w = pk2(a1.z, a1.w);
          *(v4u*)(Xb + ((size_t)b * RPB + j) * 2048 + c8 * 8) = w; } }
    { float* rope = (float*)(FWS + WS_ROPE); const int gt = F.vcu * NTHREADS + F.tid;
      if (gt < 192 * 32) { const int p = gt >> 5, f = gt & 31; const float inv = powf(10000.0f, -(float)f / 32.0f);
          if (p < 128) { const float ang = (float)p * inv; rope[p * 32 + f] = cosf(ang); rope[4096 + p * 32 + f] = sinf(ang); }
          else { const float ang = (float)(p - 128) * inv; rope[8192 + (p - 128) * 32 + f] = cosf(ang); rope[8192 + 2048 + (p - 128) * 32 + f] = sinf(ang); } } }
    LAS float* scr = (LAS float*)(F.lds + F.wave * 16384);
    constexpr int I_IN = 32 * 112, I_OUT = 24 * 64, I_F1 = 32 * 256, I_F2 = 128 * 64, I_FOLD = 32 * 64, I_L = I_IN + I_OUT + I_F1 + I_F2 + I_FOLD;
    for (int it = F.gw; it < 2 * I_L; it += F.NGW) {
        const int l = it / I_L; int r = it % I_L; unsigned char* wl = FWS + WS_W + (size_t)l * WL_BYTES;
        if (r < I_IN) { p0_transpose_item(FIN(8) + (size_t)l * 2048 * 3584, 2048, 3584, (bf16raw*)(wl + WO_IN), scr, r / 112, r % 112, F.lane); continue; } r -= I_IN;
        if (r < I_OUT) { int kb = r / 64; kb = kb < 16 ? kb : kb + 8; p0_transpose_item(FIN(14) + (size_t)l * 2048 * 2048, 2048, 2048, (bf16raw*)(wl + WO_OUT), scr, kb, r % 64, F.lane); continue; } r -= I_OUT;
        if (r < I_F1) { p0_transpose_item(FIN(15) + (size_t)l * 2048 * 8192, 2048, 8192, (bf16raw*)(wl + WO_FF1), scr, r / 256, r % 256, F.lane); continue; } r -= I_F1;
        if (r < I_F2) { p0_transpose_item(FIN(16) + (size_t)l * 8192 * 2048, 8192, 2048, (bf16raw*)(wl + WO_FF2), scr, r / 64, r % 64, F.lane); continue; } r -= I_F2;
        p0_fold_item(FIN(11) + (size_t)l * 4 * 128 * 128, FIN(12) + (size_t)l * 512, FIN(14) + (size_t)l * 2048 * 2048, (bf16raw*)(wl + WO_OUT), r, F.lane);
    }
}

__device__ __forceinline__ void norm_phase(unsigned char* lds_, int l, int which  , int src_in, int skip_ctx, int nslab, const float* slab, int gate_off, int write_x) {
    KArgs ka = kargs(); Frame F; F.init(lds_);
    LAS float* GS = (LAS float*)F.lds; LAS float* SH = GS + 3 * 2048;
    const float* mod = (const float*)(FWS + WS_MOD) + (size_t)l * 3 * 12288; const float* g = (which == 1 ? FIN(6) : FIN(7)) + l * 2048;
    const int shc = which == 1 ? 0 : 3, scc = shc + 1;
    for (int idx = F.tid; idx < 3 * 2048; idx += NTHREADS) { const int s = idx >> 11, c = idx & 2047; GS[idx] = g[c] * (1.f + mod[s * 12288 + scc * 2048 + c]); SH[idx] = mod[s * 12288 + shc * 2048 + c]; }
    __syncthreads();
    bf16raw* Xb = (bf16raw*)(FWS + WS_X); bf16raw* H = (bf16raw*)(FWS + WS_H);
    const float* mod0 = (const float*)(FWS + WS_MOD);
    constexpr int NR = 4;
    for (int r0 = F.gw; r0 < MROWS; r0 += NR * F.NGW) {
        float v[NR][4][8]; int sidx[NR]; bool act[NR];
#pragma unroll
        for (int q = 0; q < NR; ++q) {
            const int r = r0 + q * F.NGW; const int rr = r < MROWS ? r : r0; const int b = rr / RPB, j = rr % RPB; const bool isctx = j < CTX;
            act[q] = r < MROWS && !(isctx && skip_ctx); sidx[q] = isctx ? 2 : b;
            if (src_in) { const float* xr = isctx ? FIN(2) + ((size_t)b * CTX + j) * 2048 : FIN(0) + ((size_t)b * SEQ + (j - CTX)) * 2048;
#pragma unroll
                for (int jj = 0; jj < 4; ++jj) { const v4f a0 = *(const v4f*)(xr + F.lane * 8 + 512 * jj), a1 = *(const v4f*)(xr + F.lane * 8 + 512 * jj + 4);
                    v[q][jj][0] = a0.x; v[q][jj][1] = a0.y; v[q][jj][2] = a0.z; v[q][jj][3] = a0.w; v[q][jj][4] = a1.x; v[q][jj][5] = a1.y; v[q][jj][6] = a1.z; v[q][jj][7] = a1.w; } }
            else {
#pragma unroll
                for (int jj = 0; jj < 4; ++jj) unpack8(*(const v4u*)(Xb + (size_t)rr * 2048 + F.lane * 8 + 512 * jj), v[q][jj]); }
            if (nslab > 0 && isctx && act[q]) {
                const float* sp = slab + ((size_t)b * CTX + j) * 2048 + F.lane * 8; const float* gp = mod0 + gate_off + F.lane * 8;
                v4f sacc[4][2];
#pragma unroll
                for (int jj = 0; jj < 4; ++jj) { sacc[jj][0] = (v4f){0.f, 0.f, 0.f, 0.f}; sacc[jj][1] = sacc[jj][0]; }
#pragma unroll 2
                for (int k = 0; k < nslab; ++k) {
#pragma unroll
                    for (int jj = 0; jj < 4; ++jj) { sacc[jj][0] += *(const v4f*)(sp + (size_t)k * 512 * 2048 + 512 * jj); sacc[jj][1] += *(const v4f*)(sp + (size_t)k * 512 * 2048 + 512 * jj + 4); } }
#pragma unroll
                for (int jj = 0; jj < 4; ++jj) { const v4f g0 = *(const v4f*)(gp + 512 * jj), g1 = *(const v4f*)(gp + 512 * jj + 4);
                    v[q][jj][0] += g0.x * sacc[jj][0].x; v[q][jj][1] += g0.y * sacc[jj][0].y; v[q][jj][2] += g0.z * sacc[jj][0].z; v[q][jj][3] += g0.w * sacc[jj][0].w;
                    v[q][jj][4] += g1.x * sacc[jj][1].x; v[q][jj][5] += g1.y * sacc[jj][1].y; v[q][jj][6] += g1.z * sacc[jj][1].z; v[q][jj][7] += g1.w * sacc[jj][1].w;
                    if (write_x) *(v4u*)(Xb + (size_t)rr * 2048 + F.lane * 8 + 512 * jj) = pack8(v[q][jj]); }
            }
        }
#pragma unroll
        for (int q = 0; q < NR; ++q) {
            float ss = 0.f;
#pragma unroll
            for (int jj = 0; jj < 4; ++jj)
#pragma unroll
                for (int i = 0; i < 8; ++i) ss += v[q][jj][i] * v[q][jj][i];
            const float rstd = 1.f / sqrtf(wave_sum(ss) * (1.f / 2048.f) + EPS);
            if (act[q]) { bf16raw* hr = H + (size_t)(r0 + q * F.NGW) * 2048; const int s = sidx[q];
#pragma unroll
                for (int jj = 0; jj < 4; ++jj) { const int c = F.lane * 8 + 512 * jj;
                    const v4f g0 = *(const LAS v4f*)(GS + s * 2048 + c), g1 = *(const LAS v4f*)(GS + s * 2048 + c + 4), h0 = *(const LAS v4f*)(SH + s * 2048 + c), h1 = *(const LAS v4f*)(SH + s * 2048 + c + 4);
                    float o[8]; o[0] = v[q][jj][0] * rstd * g0.x + h0.x; o[1] = v[q][jj][1] * rstd * g0.y + h0.y; o[2] = v[q][jj][2] * rstd * g0.z + h0.z; o[3] = v[q][jj][3] * rstd * g0.w + h0.w;
                    o[4] = v[q][jj][4] * rstd * g1.x + h1.x; o[5] = v[q][jj][5] * rstd * g1.y + h1.y; o[6] = v[q][jj][6] * rstd * g1.z + h1.z; o[7] = v[q][jj][7] * rstd * g1.w + h1.w;
                    *(v4u*)(hr + c) = pack8(o); } }
        }
    }
    __syncthreads();
}

constexpr float QSCALE = 0.088388347648318440f * 1.4426950408889634f;
struct RopeCS { v4f c0, c1, s0, s1; };
__device__ __forceinline__ void normrope8(float* x, const v4f g0, const v4f g1, const RopeCS& rc, bool dorope, int lane) {
    const int sub = lane & 15, quarter = sub >> 2;
    float ss = 0.f;
#pragma unroll
    for (int i = 0; i < 8; ++i) ss += x[i] * x[i];
    ss += __shfl_xor(ss, 1); ss += __shfl_xor(ss, 2); ss += __shfl_xor(ss, 4); ss += __shfl_xor(ss, 8);
    const float rstd = 1.f / sqrtf(ss * (1.f / 128.f) + EPS);
    x[0] *= rstd * g0.x; x[1] *= rstd * g0.y; x[2] *= rstd * g0.z; x[3] *= rstd * g0.w; x[4] *= rstd * g1.x; x[5] *= rstd * g1.y; x[6] *= rstd * g1.z; x[7] *= rstd * g1.w;
    float p[8];
#pragma unroll
    for (int i = 0; i < 8; ++i) p[i] = __shfl_xor(x[i], 4);
    if (dorope) {
        const float cs[8] = {rc.c0.x, rc.c0.y, rc.c0.z, rc.c0.w, rc.c1.x, rc.c1.y, rc.c1.z, rc.c1.w}, sn[8] = {rc.s0.x, rc.s0.y, rc.s0.z, rc.s0.w, rc.s1.x, rc.s1.y, rc.s1.z, rc.s1.w};
        const float sg = (quarter & 1) ? 1.f : -1.f;
#pragma unroll
        for (int i = 0; i < 8; ++i) x[i] = x[i] * cs[i] + sg * p[i] * sn[i];
    }
}
__device__ __forceinline__ void a2_phase(unsigned char* lds_, int l, int last) {
    KArgs ka = kargs(); Frame F; F.init(lds_);
    bf16raw* P = (bf16raw*)(FWS + WS_P); bf16raw* CAT = (bf16raw*)(FWS + WS_CAT); bf16raw* KV = (bf16raw*)(FWS + WS_KV); bf16raw* QN = (bf16raw*)(FWS + WS_QN);
    const float* rope = (const float*)(FWS + WS_ROPE);
    const int lane = F.lane, sub = lane & 15, quarter = sub >> 2, f0 = (sub & 3) * 8;
    const v4f qg0 = *(const v4f*)(FIN(9) + l * 128 + sub * 8), qg1 = *(const v4f*)(FIN(9) + l * 128 + sub * 8 + 4);
    const v4f kg0 = *(const v4f*)(FIN(10) + l * 128 + sub * 8), kg1 = *(const v4f*)(FIN(10) + l * 128 + sub * 8 + 4);
    const float* cw = FIN(13) + (size_t)l * 3 * 512 + lane * 8;
    v4f cwv[3][2];
#pragma unroll
    for (int jj = 0; jj < 3; ++jj) { cwv[jj][0] = *(const v4f*)(cw + jj * 512); cwv[jj][1] = *(const v4f*)(cw + jj * 512 + 4); }
    const int gi = lane >> 4, lo = 1 << gi;
    for (int r = F.gw; r < MROWS; r += F.NGW) {
        const int b = r / RPB, j = r % RPB; const bool isctx = j < CTX; const int pos = j - CTX, prow = isctx ? 0 : pos >> 6, pcol = isctx ? 0 : pos & 63;
        const int t = isctx ? j : pos, n = isctx ? CTX : SEQ; const bool full = !(isctx && last);
        bf16raw* Pr = P + (size_t)r * INW;
        const v4u kvraw = *(const v4u*)(Pr + K_OFF + lane * 8);
        RopeCS rc;
        { const int co = quarter < 2 ? prow * 32 + f0 : 8192 + pcol * 32 + f0, so = co + (quarter < 2 ? 4096 : 2048);
          rc.c0 = *(const v4f*)(rope + co); rc.c1 = *(const v4f*)(rope + co + 4); rc.s0 = *(const v4f*)(rope + so); rc.s1 = *(const v4f*)(rope + so + 4); }
        if (full) {
            const v4u q0 = *(const v4u*)(Pr + lane * 8), q1 = *(const v4u*)(Pr + 512 + lane * 8);
            v4u pw[16];
            const bf16raw* pb = P + (size_t)(r - t) * INW + POOL_OFF + lane * 8;
#pragma unroll
            for (int d = 0; d < 16; ++d) { int tt = t - 8 + d; tt = tt < 0 ? 0 : (tt > n - 1 ? n - 1 : tt); pw[d] = *(const v4u*)(pb + (size_t)tt * INW); }
            const v4u cbr = *(const v4u*)(Pr + CB_OFF + lane * 8);
            v4u ccr[3], cvr[3];
#pragma unroll
            for (int jj = 0; jj < 3; ++jj) { int tt = t + jj - 1; tt = tt < 0 ? 0 : (tt > n - 1 ? n - 1 : tt); const bf16raw* p2 = P + (size_t)(r - t + tt) * INW + lane * 8; ccr[jj] = *(const v4u*)(p2 + CC_OFF); cvr[jj] = *(const v4u*)(p2 + CV_OFF); }
            { float x[8]; unpack8(q0, x); normrope8(x, qg0, qg1, rc, !isctx, lane);
#pragma unroll
              for (int i = 0; i < 8; ++i) x[i] *= QSCALE;
              *(v4u*)(QN + (size_t)r * 1024 + lane * 8) = pack8(x); }
            { float x[8]; unpack8(q1, x); normrope8(x, qg0, qg1, rc, !isctx, lane);
#pragma unroll
              for (int i = 0; i < 8; ++i) x[i] *= QSCALE;
              *(v4u*)(QN + (size_t)r * 1024 + 512 + lane * 8) = pack8(x); }
            { float acc[8], me[8];
#pragma unroll
              for (int i = 0; i < 8; ++i) acc[i] = 0.f;
              int cnt = 0;
#pragma unroll
              for (int d = 0; d < 16; ++d) { const int dt = d - 8, tt = t + dt; const bool ok = dt >= -lo && dt < lo && tt >= 0 && tt < n; float x[8]; unpack8(pw[d], x); const float m = ok ? 1.f : 0.f; cnt += ok ? 1 : 0;
#pragma unroll
                  for (int i = 0; i < 8; ++i) acc[i] += m * x[i]; }
              unpack8(pw[8], me); const float ic = 1.f / (float)cnt;
#pragma unroll
              for (int i = 0; i < 8; ++i) acc[i] = acc[i] * ic - me[i];
              *(v4u*)(CAT + (size_t)r * 2048 + 1024 + lane * 8) = pack8(acc); }
            { float cb[8], acc[8]; unpack8(cbr, cb);
#pragma unroll
              for (int i = 0; i < 8; ++i) acc[i] = 0.f;
#pragma unroll
              for (int jj = 0; jj < 3; ++jj) { const int tt = t + jj - 1; const float m = (tt >= 0 && tt < n) ? 1.f : 0.f; float a[8], v[8]; unpack8(ccr[jj], a); unpack8(cvr[jj], v);
                  const float ww[8] = {cwv[jj][0].x, cwv[jj][0].y, cwv[jj][0].z, cwv[jj][0].w, cwv[jj][1].x, cwv[jj][1].y, cwv[jj][1].z, cwv[jj][1].w};
#pragma unroll
                  for (int i = 0; i < 8; ++i) acc[i] += m * a[i] * v[i] * ww[i]; }
#pragma unroll
              for (int i = 0; i < 8; ++i) acc[i] *= cb[i];
              *(v4u*)(CAT + (size_t)r * 2048 + 1536 + lane * 8) = pack8(acc); }
        }
        { float x[8]; unpack8(kvraw, x); normrope8(x, kg0, kg1, rc, !isctx, lane); const v4u kn = pack8(x); const int hd = (lane >> 4) & 1;
          bf16raw* dst = KV + (lane < 32 ? (size_t)0 : (size_t)NB * 2 * RPB * 128) + ((size_t)(b * 2 + hd) * RPB + j) * 128 + sub * 8; *(v4u*)dst = lane < 32 ? kn : kvraw; }
    }
}

__device__ __forceinline__ void attn_phase(unsigned char* lds_, int last) {
    KArgs ka = kargs(); Frame F; F.init(lds_); char* lds = (char*)lds_;
    const att::bf16* QN = (const att::bf16*)(FWS + WS_QN); const att::bf16* KV = (const att::bf16*)(FWS + WS_KV); att::bf16* CAT = (att::bf16*)(FWS + WS_CAT);
    const int nlat = 512, nctx = last ? 0 : 16;
    for (int i = 0;; ++i) {
        const int idx = i * F.G + F.vcu; if (idx >= nlat + nctx) break;
        int b, h, qrow, seq;
        if (idx < nlat) { const int per = F.G >= 4 ? F.G / 4 : 1; int u;
            if (F.G == 256) { const int combo = F.vcu / per, k = F.vcu % per; u = combo * 128 + k + i * per; } else u = idx;
            const int combo = u >> 7, w = u & 127; b = combo >> 1; h = (combo & 1) * 4 + (w >> 5); qrow = b * RPB + CTX + (w & 31) * 256; seq = RPB; }
        else { const int e = idx - nlat; b = e >> 3; h = e & 7; qrow = b * RPB; seq = CTX; }
        const int kvh = h >> 2;
        att::attn_dense_body<1024, 128, 2048>(QN + (size_t)qrow * 1024 + h * 128, KV + (size_t)(b * 2 + kvh) * RPB * 128, KV + (size_t)NB * 2 * RPB * 128 + (size_t)(b * 2 + kvh) * RPB * 128,
                                             CAT + (size_t)qrow * 2048 + h * 128, seq, lds);
    }
}

#ifndef REP_PREP
#define REP_PREP 1
#endif
#ifndef REP_NORM
#define REP_NORM 1
#endif
#ifndef REP_ATTN
#define REP_ATTN 1
#endif
#ifndef REP_INPROJ
#define REP_INPROJ 1
#endif
#ifndef SPLITK_CTX
#define SPLITK_CTX 1
#endif
#ifndef REP_A2
#define REP_A2 1
#endif
#ifndef REP_BAR
#define REP_BAR 0
#endif
#ifndef REP_OUTPROJ
#define REP_OUTPROJ 1
#endif
#ifndef REP_FF2
#define REP_FF2 1
#endif
#ifndef REP_FF1
#define REP_FF1 1
#endif
__global__ void __launch_bounds__(NTHREADS, 2) fwd_megakernel(Args args) {
    extern __shared__ __attribute__((aligned(16))) unsigned char lds[];
    cg::grid_group grid = cg::this_grid();
    if (threadIdx.x < 2) ((LAS unsigned*)((LAS unsigned char*)lds + XB_LDS_OFF))[threadIdx.x] = 0u;
    __syncthreads();
    if (blockIdx.x == 0) { KArgs ka = kargs(); unsigned* bw = (unsigned*)(ka->ws + WS_CTL) + XB_WORD0; for (int i = threadIdx.x; i < XCD_BAR_WORDS; i += NTHREADS) bw[i] = 0u; }
    for (int rep_ = 0; rep_ < REP_PREP; ++rep_) { p0_prologue(lds); __syncthreads(); }
    grid.sync();
    { KArgs ka = kargs(); (void)xcd_barrier_post((unsigned*)(ka->ws + WS_CTL) + XB_WORD0, (volatile LAS unsigned*)((LAS unsigned char*)lds + XB_LDS_OFF)); }
#pragma unroll 1
    for (int l = 0; l < 2; ++l) {
        const int last = l == 1;
        for (int rep_ = 0; rep_ < REP_NORM; ++rep_) norm_phase(lds, l, 1, l == 0, 0, (SPLITK_CTX && l == 1) ? 16 : 0, (const float*)kargs()->out, (0 * 3 + 2) * 12288 + 5 * 2048, 0);
        grid_bar(lds);
        for (int rep_ = 0; rep_ < REP_INPROJ; ++rep_) {
            KArgs ka = kargs(); unsigned char* wl = FWS + WS_W + (size_t)l * WL_BYTES;
            pg8::Gemm g{(const pg8::bf16_t*)(FWS + WS_H), (const pg8::bf16_t*)(wl + WO_IN), MROWS, INW, DM, DM}; pg8::TileOrder S; S.init(INW, gridDim.x, fresh_bid(), last ? 2 : 0);
            pg8::EpiBf16<0> E{(pg8::bf16_t*)(FWS + WS_P), INW};
            pg8::gemm_phase<pg8::EpiBf16<0>, pg8::TileOrder, true, true>((LAS unsigned char*)lds, g, S, E);
        }
        grid_bar(lds);
        for (int rep_ = 0; rep_ < REP_A2; ++rep_) a2_phase(lds, l, last);
        grid_bar(lds);
        for (int rep_ = 0; rep_ < REP_ATTN; ++rep_) attn_phase(lds, last);
        grid_bar(lds);
        for (int rep_ = 0; rep_ < REP_BAR; ++rep_) grid_bar(lds);
        for (int rep_ = 0; rep_ < REP_OUTPROJ; ++rep_) {
            KArgs ka = kargs(); unsigned char* wl = FWS + WS_W + (size_t)l * WL_BYTES; pg8::bf16_t* X = (pg8::bf16_t*)(FWS + WS_X); const float* mod = (const float*)(FWS + WS_MOD);
            pg8::Gemm g{(const pg8::bf16_t*)(FWS + WS_CAT), (const pg8::bf16_t*)(wl + WO_OUT), MROWS, DM, DM, DM}; pg8::TileOrder S; S.init(DM, gridDim.x, fresh_bid(), (SPLITK_CTX || last) ? 1 : 0);
            pg8::EpiGateRes E{mod + (size_t)l * 3 * 12288 + 2 * 2048, FIN(0), FIN(2), X, ka->out, l == 0 ? 1 : 0, rep_ + 1 < REP_OUTPROJ ? 1 : 0};
            pg8::gemm_phase<pg8::EpiGateRes, pg8::TileOrder, true, true>((LAS unsigned char*)lds, g, S, E);
        }
        if (SPLITK_CTX && !last) {
            KArgs ka = kargs(); unsigned char* wl = FWS + WS_W + (size_t)l * WL_BYTES;
            const int c = fresh_bid(), tile = c >> 3, kc = c & 7;
            pg8::Gemm g{(const pg8::bf16_t*)(FWS + WS_CAT) + kc * 256, (const pg8::bf16_t*)(wl + WO_OUT) + kc * 256, MROWS, DM, 256, DM};
            pg8::OneUnit S{(tile >> 3) * 33, tile & 7, c < 128};
            pg8::EpiSlab E{ka->out + (size_t)(16 + kc) * 512 * 2048};
            pg8::gemm_phase<pg8::EpiSlab, pg8::OneUnit, false, true>((LAS unsigned char*)lds, g, S, E);
        }
        grid_bar(lds);
        for (int rep_ = 0; rep_ < REP_NORM; ++rep_) norm_phase(lds, l, 2, 0, last, (SPLITK_CTX && l == 0) ? 8 : 0, (const float*)kargs()->out + (size_t)16 * 512 * 2048, (0 * 3 + 2) * 12288 + 2 * 2048, 1);
        grid_bar(lds);
        for (int rep_ = 0; rep_ < REP_FF1; ++rep_) {
            KArgs ka = kargs(); unsigned char* wl = FWS + WS_W + (size_t)l * WL_BYTES;
            pg8::Gemm g{(const pg8::bf16_t*)(FWS + WS_H), (const pg8::bf16_t*)(wl + WO_FF1), MROWS, DFF, DM, DM}; pg8::TileOrder S; S.init(DFF, gridDim.x, fresh_bid(), last ? 1 : 0);
            pg8::EpiBf16<2> E{(pg8::bf16_t*)(FWS + WS_U), DFF};
            pg8::gemm_phase<pg8::EpiBf16<2>, pg8::TileOrder, true, true>((LAS unsigned char*)lds, g, S, E);
        }
        grid_bar(lds);
        for (int rep_ = 0; rep_ < REP_FF2; ++rep_) {
            KArgs ka = kargs(); unsigned char* wl = FWS + WS_W + (size_t)l * WL_BYTES; pg8::bf16_t* X = (pg8::bf16_t*)(FWS + WS_X); const float* mod = (const float*)(FWS + WS_MOD);
            pg8::Gemm g{(const pg8::bf16_t*)(FWS + WS_U), (const pg8::bf16_t*)(wl + WO_FF2), MROWS, DM, DFF, DFF}; pg8::TileOrder S; S.init(DM, gridDim.x, fresh_bid(), (SPLITK_CTX || last) ? 1 : 0);
            pg8::EpiGateRes E{mod + (size_t)l * 3 * 12288 + 5 * 2048, FIN(0), FIN(2), X, ka->out, 0, (rep_ + 1 < REP_FF2) ? 1 : last};
            pg8::gemm_phase<pg8::EpiGateRes, pg8::TileOrder, true, true>((LAS unsigned char*)lds, g, S, E);
        }
        if (SPLITK_CTX && !last) {
            KArgs ka = kargs(); unsigned char* wl = FWS + WS_W + (size_t)l * WL_BYTES;
            const int c = fresh_bid(), tile = c >> 4, kc = c & 15;
            pg8::Gemm g{(const pg8::bf16_t*)(FWS + WS_U) + kc * 512, (const pg8::bf16_t*)(wl + WO_FF2) + kc * 512, MROWS, DM, 512, DFF};
            pg8::OneUnit S{(tile >> 3) * 33, tile & 7, c < 256};
            pg8::EpiSlab E{ka->out + (size_t)kc * 512 * 2048};
            pg8::gemm_phase<pg8::EpiSlab, pg8::OneUnit, false, true>((LAS unsigned char*)lds, g, S, E);
        }
        if (!last) grid_bar(lds);
    }
}

extern "C" void kernel_launch(void* const* d_in, const int* in_sizes, int n_in, void* d_out, int out_size, void* d_ws, size_t ws_size, hipStream_t stream) {
    static int grid = 0;
    if (grid == 0) {
        if (n_in != 17 || in_sizes[0] != NB * SEQ * DM || out_size != NB * SEQ * DM || ws_size < WS_END) {
            fprintf(stderr, "kernel_launch: unexpected shapes (n_in %d, in0 %d, out %d, ws %zu; need ws >= %zu)\n", n_in, n_in > 0 ? in_sizes[0] : -1, out_size, ws_size, (size_t)WS_END); grid = -1; return; }
        int dev = 0, cus = 0, per_cu = 0;
        if (hipGetDevice(&dev) != hipSuccess || hipDeviceGetAttribute(&cus, hipDeviceAttributeMultiprocessorCount, dev) != hipSuccess) { grid = -1; return; }
        if (hipFuncSetAttribute((const void*)fwd_megakernel, hipFuncAttributeMaxDynamicSharedMemorySize, LDS_BYTES) != hipSuccess) { fprintf(stderr, "kernel_launch: hipFuncSetAttribute failed\n"); grid = -1; return; }
        if (hipOccupancyMaxActiveBlocksPerMultiprocessor(&per_cu, (const void*)fwd_megakernel, NTHREADS, LDS_BYTES) != hipSuccess || per_cu < 1) { fprintf(stderr, "kernel_launch: occupancy query gave %d\n", per_cu); per_cu = 1; }
        (void)hipGetLastError();
        grid = cus * per_cu;
    }
    if (grid < 0) return;
    Args a{};
    for (int i = 0; i < 17; ++i) a.in[i] = (const float*)d_in[i];
    a.out = (float*)d_out; a.ws = (unsigned char*)d_ws;
    void* params[] = {&a};
    const hipError_t e = hipLaunchCooperativeKernel((const void*)fwd_megakernel, dim3(grid), dim3(NTHREADS), params, LDS_BYTES, stream);
    if (e != hipSuccess) fprintf(stderr, "kernel_launch: cooperative launch failed: %s (grid %d)\n", hipGetErrorString(e), grid);
}
```
